# Optimizing an MI355X kernel written in HIP

```python
import jax, jax.numpy as jnp
from jax import lax
import numpy as np

D_MODEL = 1024
BATCH = 2
SEQ = 16384
DEPTH = 4

N_MIXERS = 2
D_MIX = D_MODEL
MEM_LEN = 256
MEM_HEADS = 4
MEM_HEAD_DIM = 64
MEM_WIDTH = MEM_HEADS * MEM_HEAD_DIM
TOK_WIDTH = D_MIX - MEM_WIDTH
LRU_WIDTH = TOK_WIDTH
LRU_BLOCKS = 8
LRU_BLOCK_DIM = LRU_WIDTH // LRU_BLOCKS
CONV_WIDTH = 4
CONV_PAD = (2, 1)
LRU_C = 8.0
MLA_HEADS = 12
QK_NOPE_DIM = 64
QK_ROPE_DIM = 32
QK_DIM = QK_NOPE_DIM + QK_ROPE_DIM
V_HEAD_DIM = TOK_WIDTH // MLA_HEADS
Q_LORA_RANK = 384
KV_LORA_RANK = 256
ROPE_THETA = 10000.0
Q_BLOCK = 128
D_FF = 2816
EPS = 1e-6
N_LRU_LAYERS = (DEPTH + 1) // 2
N_MLA_LAYERS = DEPTH // 2
LRU_IN_WIDTH = 2 * LRU_WIDTH + MEM_WIDTH
MLA_TOK_IN_WIDTH = Q_LORA_RANK + KV_LORA_RANK + QK_ROPE_DIM
MLA_IN_WIDTH = MLA_TOK_IN_WIDTH + MEM_WIDTH

kernel_name = 'hybrid_rglru_mla_macaron_encoder'


def rms_norm(x, g):
    xf = x.astype(jnp.float32)
    y = xf * lax.rsqrt(jnp.mean(xf * xf, axis=-1, keepdims=True) + EPS)
    return (y * g.astype(jnp.float32)).astype(x.dtype)


def swiglu_ffn(x, w_gate_up, w_down):
    g, u = jnp.split(x @ w_gate_up, [D_FF], axis=-1)
    return (jax.nn.silu(g) * u) @ w_down


def rope_tables(positions):
    half = QK_ROPE_DIM // 2
    inv_freq = ROPE_THETA ** (-jnp.arange(half, dtype=jnp.float32) * (2.0 / QK_ROPE_DIM))
    ang = positions.astype(jnp.float32)[..., None] * inv_freq
    return jnp.cos(ang)[:, :, None, :], jnp.sin(ang)[:, :, None, :]


def apply_rope(x, cos, sin):
    half = QK_ROPE_DIM // 2
    xf = x.astype(jnp.float32)
    x1, x2 = xf[..., :half], xf[..., half:]
    return jnp.concatenate([x1 * cos - x2 * sin, x2 * cos + x1 * sin], axis=-1).astype(x.dtype)


def memory_attention(q_in, mem_n, w_mem_kv, q_gain, k_gain):
    B, S, _ = q_in.shape
    q = rms_norm(q_in.reshape(B, S, MEM_HEADS, MEM_HEAD_DIM), q_gain)
    k, v = jnp.split(mem_n @ w_mem_kv, [MEM_WIDTH], axis=-1)
    k = rms_norm(k.reshape(B, -1, MEM_HEADS, MEM_HEAD_DIM), k_gain)
    v = v.reshape(B, -1, MEM_HEADS, MEM_HEAD_DIM)
    s = jnp.einsum('bshd,bmhd->bhsm', q.astype(jnp.float32), k.astype(jnp.float32)) * (MEM_HEAD_DIM ** -0.5)
    p = jax.nn.softmax(s, axis=-1).astype(v.dtype)
    return jnp.einsum('bhsm,bmhd->bshd', p, v).reshape(B, S, MEM_WIDTH)


def _linear_combine(left, right):
    a1, b1 = left
    a2, b2 = right
    return a1 * a2, a2 * b1 + b2


def rglru_direction(xc, gate_w, gate_b, lam, reverse):
    B, S, _ = xc.shape
    xb = xc.reshape(B, S, LRU_BLOCKS, LRU_BLOCK_DIM)
    gates = jnp.einsum('bsnk,gnkj->gbsnj', xb, gate_w).reshape(2, B, S, LRU_WIDTH)
    gates = gates.astype(jnp.float32) + gate_b.astype(jnp.float32)[:, None, None, :]
    r_gate = jax.nn.sigmoid(gates[0])
    i_gate = jax.nn.sigmoid(gates[1])
    log_a = -LRU_C * r_gate * jax.nn.softplus(-lam.astype(jnp.float32))
    a = jnp.exp(log_a)
    b = jnp.sqrt(-jnp.expm1(2.0 * log_a)) * (i_gate * xc.astype(jnp.float32))
    _, h = lax.associative_scan(_linear_combine, (a, b), reverse=reverse, axis=1)
    return h


def rglru_mixer(u, conv_w, conv_b, gate_w, gate_b, lam):
    gate_branch, xr = jnp.split(u, [LRU_WIDTH], axis=-1)
    xc = lax.conv_general_dilated(
        xr, conv_w[:, None, :].astype(xr.dtype), window_strides=(1,), padding=[CONV_PAD],
        dimension_numbers=('NWC', 'WIO', 'NWC'), feature_group_count=LRU_WIDTH) + conv_b
    h = (rglru_direction(xc, gate_w[0], gate_b[0], lam[0], False)
         + rglru_direction(xc, gate_w[1], gate_b[1], lam[1], True))
    return h.astype(u.dtype) * jax.nn.gelu(gate_branch)


def dense_attention(q, k, v):
    B, S, H, D = q.shape
    nb = S // Q_BLOCK
    qb = q.reshape(B, nb, Q_BLOCK, H, D).transpose(1, 0, 2, 3, 4)
    kf = k.astype(jnp.float32)
    scale = QK_DIM ** -0.5

    def one_block(q_blk):
        s = jnp.einsum('bqhd,bkhd->bhqk', q_blk.astype(jnp.float32), kf) * scale
        p = jax.nn.softmax(s, axis=-1).astype(v.dtype)
        return jnp.einsum('bhqk,bkhv->bqhv', p, v)

    o = lax.map(one_block, qb)
    return o.transpose(1, 0, 2, 3, 4).reshape(B, S, H * V_HEAD_DIM)


def mla_mixer(u, q_a_norm, w_uq, kv_a_norm, w_ukv, q_norm, k_norm, cos, sin):
    B, S, _ = u.shape
    c_q, c_kv, k_rope = jnp.split(u, [Q_LORA_RANK, Q_LORA_RANK + KV_LORA_RANK], axis=-1)
    q = (rms_norm(c_q, q_a_norm) @ w_uq).reshape(B, S, MLA_HEADS, QK_DIM)
    kv = (rms_norm(c_kv, kv_a_norm) @ w_ukv).reshape(B, S, MLA_HEADS, QK_NOPE_DIM + V_HEAD_DIM)
    k_nope, v = jnp.split(kv, [QK_NOPE_DIM], axis=-1)
    k_rope = jnp.broadcast_to(k_rope[:, :, None, :], (B, S, MLA_HEADS, QK_ROPE_DIM))
    k = jnp.concatenate([k_nope, k_rope], axis=-1)
    q = rms_norm(q, q_norm)
    k = rms_norm(k, k_norm)
    q = jnp.concatenate([q[..., :QK_NOPE_DIM], apply_rope(q[..., QK_NOPE_DIM:], cos, sin)], axis=-1)
    k = jnp.concatenate([k[..., :QK_NOPE_DIM], apply_rope(k[..., QK_NOPE_DIM:], cos, sin)], axis=-1)
    return dense_attention(q, k, v)


def setup_inputs(seed: int = 0) -> dict:
    key = jax.random.key(seed)
    ks = iter(jax.random.split(key, 40))

    def w(shape, fan_in):
        return jax.random.normal(next(ks), shape, jnp.float32) * (fan_in ** -0.5)

    def gain(shape):
        return 1.0 + 0.02 * jax.random.normal(next(ks), shape, jnp.float32)

    def bias(shape):
        return 0.01 * jax.random.normal(next(ks), shape, jnp.float32)

    x = jax.random.normal(next(ks), (BATCH, SEQ, D_MODEL), jnp.float32)
    mem = jax.random.normal(next(ks), (BATCH, MEM_LEN, D_MODEL), jnp.float32)
    positions = jnp.broadcast_to(jnp.arange(SEQ, dtype=jnp.int32), (BATCH, SEQ))
    a_c = jax.random.uniform(next(ks), (N_LRU_LAYERS, 2, LRU_WIDTH), jnp.float32, 0.9, 0.999)
    a0 = a_c ** (1.0 / LRU_C)
    lru_lambda = jnp.log(a0) - jnp.log1p(-a0)
    return {
        'x': x,
        'mem': mem,
        'positions': positions,
        'ffn1_norm': gain((DEPTH, D_MODEL)),
        'ffn1_w_gate_up': w((DEPTH, D_MODEL, 2 * D_FF), D_MODEL),
        'ffn1_w_down': w((DEPTH, D_FF, D_MODEL), D_FF),
        'mix_norm': gain((DEPTH, D_MODEL)),
        'mem_norm': gain((DEPTH, D_MODEL)),
        'w_mem_kv': w((DEPTH, D_MODEL, 2 * MEM_WIDTH), D_MODEL),
        'mem_q_norm': gain((DEPTH, MEM_HEAD_DIM)),
        'mem_k_norm': gain((DEPTH, MEM_HEAD_DIM)),
        'w_out': w((DEPTH, D_MIX, D_MODEL), D_MIX),
        'ffn2_norm': gain((DEPTH, D_MODEL)),
        'ffn2_w_gate_up': w((DEPTH, D_MODEL, 2 * D_FF), D_MODEL),
        'ffn2_w_down': w((DEPTH, D_FF, D_MODEL), D_FF),
        'lru_w_in': w((N_LRU_LAYERS, D_MODEL, LRU_IN_WIDTH), D_MODEL),
        'lru_conv_w': w((N_LRU_LAYERS, CONV_WIDTH, LRU_WIDTH), CONV_WIDTH),
        'lru_conv_b': bias((N_LRU_LAYERS, LRU_WIDTH)),
        'lru_gate_w': w((N_LRU_LAYERS, 2, 2, LRU_BLOCKS, LRU_BLOCK_DIM, LRU_BLOCK_DIM), LRU_BLOCK_DIM),
        'lru_gate_b': bias((N_LRU_LAYERS, 2, 2, LRU_WIDTH)),
        'lru_lambda': lru_lambda,
        'mla_w_in': w((N_MLA_LAYERS, D_MODEL, MLA_IN_WIDTH), D_MODEL),
        'mla_q_a_norm': gain((N_MLA_LAYERS, Q_LORA_RANK)),
        'mla_w_uq': w((N_MLA_LAYERS, Q_LORA_RANK, MLA_HEADS * QK_DIM), Q_LORA_RANK),
        'mla_kv_a_norm': gain((N_MLA_LAYERS, KV_LORA_RANK)),
        'mla_w_ukv': w((N_MLA_LAYERS, KV_LORA_RANK, MLA_HEADS * (QK_NOPE_DIM + V_HEAD_DIM)), KV_LORA_RANK),
        'mla_q_norm': gain((N_MLA_LAYERS, QK_DIM)),
        'mla_k_norm': gain((N_MLA_LAYERS, QK_DIM)),
    }


def reference(x, mem, positions, ffn1_norm, ffn1_w_gate_up, ffn1_w_down, mix_norm, mem_norm,
              w_mem_kv, mem_q_norm, mem_k_norm, w_out, ffn2_norm, ffn2_w_gate_up, ffn2_w_down,
              lru_w_in, lru_conv_w, lru_conv_b, lru_gate_w, lru_gate_b, lru_lambda,
              mla_w_in, mla_q_a_norm, mla_w_uq, mla_kv_a_norm, mla_w_ukv, mla_q_norm, mla_k_norm):
    cos, sin = rope_tables(positions)
    for layer in range(DEPTH):
        x = x + 0.5 * swiglu_ffn(rms_norm(x, ffn1_norm[layer]), ffn1_w_gate_up[layer], ffn1_w_down[layer])
        h = rms_norm(x, mix_norm[layer])
        mem_n = rms_norm(mem, mem_norm[layer])
        j = layer // N_MIXERS
        if layer % N_MIXERS == 0:
            u = h @ lru_w_in[j]
            u_tok, u_mem = jnp.split(u, [2 * LRU_WIDTH], axis=-1)
            tok = rglru_mixer(u_tok, lru_conv_w[j], lru_conv_b[j], lru_gate_w[j],
                              lru_gate_b[j], lru_lambda[j])
        else:
            u = h @ mla_w_in[j]
            u_tok, u_mem = jnp.split(u, [MLA_TOK_IN_WIDTH], axis=-1)
            tok = mla_mixer(u_tok, mla_q_a_norm[j], mla_w_uq[j], mla_kv_a_norm[j], mla_w_ukv[j],
                            mla_q_norm[j], mla_k_norm[j], cos, sin)
        mem_out = memory_attention(u_mem, mem_n, w_mem_kv[layer], mem_q_norm[layer], mem_k_norm[layer])
        x = x + jnp.concatenate([tok, mem_out], axis=-1) @ w_out[layer]
        x = x + 0.5 * swiglu_ffn(rms_norm(x, ffn2_norm[layer]), ffn2_w_gate_up[layer], ffn2_w_down[layer])
    return x
```

```cpp
#include <hip/hip_runtime.h>
#include <hip/hip_cooperative_groups.h>
#include <cstdio>
#include <cstdint>
namespace cg = cooperative_groups;

#define LAS __attribute__((address_space(3)))
typedef unsigned short bf16;
typedef short bf16x8 __attribute__((ext_vector_type(8)));
typedef float f32x4 __attribute__((ext_vector_type(4)));
typedef float f32x16 __attribute__((ext_vector_type(16)));
typedef unsigned u32x4 __attribute__((ext_vector_type(4)));
typedef unsigned u32x2 __attribute__((ext_vector_type(2)));

constexpr int BATCH = 2, SEQ = 16384, MTOK = BATCH * SEQ, DM = 1024, FF = 2816, NGU = 2 * FF;
constexpr int LRUW = 768, LRU_IN = 1792, MLA_INP = 1024  , MLA_IN = 928;
constexpr int QL = 384, KVL = 256, NH = 12, DQK = 96, DV = 64, NQ = NH * DQK  , NQP = 1280;
constexpr int MEML = 256, MEMH = 4;
constexpr float EPS = 1e-6f;
constexpr int NTHR = 512, NWAVES = 8;
constexpr int LDS_BYTES = 147456;
#ifndef PROBE_ATTN_REPS
#define PROBE_ATTN_REPS 1
#endif
#ifndef PROBE_LRU_REPS
#define PROBE_LRU_REPS 1
#endif
#ifndef PROBE_GU_REPS
#define PROBE_GU_REPS 1
#endif
#ifndef PROBE_SMALL_REPS
#define PROBE_SMALL_REPS 1
#endif
#ifndef PROBE_SYNC2
#define PROBE_SYNC2 0
#endif
#ifndef NLAYERS_RUN
#define NLAYERS_RUN 4
#endif
#ifndef GM_MASK
#define GM_MASK 0xFFFF
#endif
#ifndef PH_MASK
#define PH_MASK 0xFFFF
#endif

constexpr size_t MiB = 1u << 20;
constexpr size_t OFF_SSQ = 466 * MiB;
constexpr size_t OFF_SSQC = 492 * MiB;
constexpr size_t OFF_SSQM = 2 * MiB + 768 * 1024;
constexpr size_t OFF_SPB = OFF_SSQM + 8192;
constexpr size_t OFF_PBUF = 3 * MiB, OFF_HEND = 6 * MiB, OFF_CARRY = 9 * MiB;
constexpr size_t OFF_MKV = 12 * MiB;
constexpr size_t OFF_MEMK = 16 * MiB, OFF_MEMVT = 17 * MiB, OFF_MEMB = 18 * MiB;
constexpr size_t OFF_WGT = 19 * MiB;
constexpr size_t OFF_WMEM = 21 * MiB;
constexpr size_t OFF_WOUT = 25 * MiB;
constexpr size_t OFF_WIN = 33 * MiB;
constexpr size_t OFF_WUQ = 44 * MiB;
constexpr size_t OFF_WKV = 46 * MiB;
constexpr size_t OFF_WGU1 = 48 * MiB, OFF_WD1 = 59 * MiB, OFF_WGU2 = 65 * MiB, OFF_WD2 = 76 * MiB;
constexpr size_t OFF_XB = 82 * MiB;
constexpr size_t OFF_H = 146 * MiB;
constexpr size_t OFF_QRAW = 322 * MiB;
constexpr size_t OFF_KH = 394 * MiB;
constexpr size_t OFF_BAR = 496 * MiB;
constexpr size_t WS_END = 497 * MiB;

typedef __bf16 bf16x2_t __attribute__((ext_vector_type(2)));
typedef float f32x2_t __attribute__((ext_vector_type(2)));
__device__ __forceinline__ unsigned cvt_pk_bf16(float lo, float hi) { f32x2_t v = {lo, hi}; bf16x2_t b = __builtin_convertvector(v, bf16x2_t); return __builtin_bit_cast(unsigned, b); }
__device__ __forceinline__ float bf2f(unsigned short b) { return __builtin_bit_cast(float, (unsigned)b << 16); }
__device__ __forceinline__ float bflo(unsigned w) { return __builtin_bit_cast(float, w << 16); }
__device__ __forceinline__ float bfhi(unsigned w) { return __builtin_bit_cast(float, w & 0xffff0000u); }
__device__ __forceinline__ float wave_sum(float v) {
#pragma unroll
    for (int o = 1; o < 64; o <<= 1) v += __shfl_xor(v, o);
    return v;
}
__device__ __forceinline__ float sum16(const float* p) { const f32x4 a = *(const f32x4*)p, b = *(const f32x4*)(p + 4), c = *(const f32x4*)(p + 8), d = *(const f32x4*)(p + 12);
    return (((a[0] + a[1]) + (a[2] + a[3])) + ((b[0] + b[1]) + (b[2] + b[3]))) + (((c[0] + c[1]) + (c[2] + c[3])) + ((d[0] + d[1]) + (d[2] + d[3]))); }
__device__ __forceinline__ float quarter_sum(const f32x4 q) { float v = (q[0] + q[1]) + (q[2] + q[3]); v += __shfl_xor(v, 16); v += __shfl_xor(v, 32); return v; }
__device__ __forceinline__ float sum8(const float* p) { const f32x4 a = *(const f32x4*)p, b = *(const f32x4*)(p + 4); return ((a[0] + a[1]) + (a[2] + a[3])) + ((b[0] + b[1]) + (b[2] + b[3])); }
__device__ __forceinline__ float sigmoidf_(float x) { return __builtin_amdgcn_rcpf(1.f + __expf(-x)); }
__device__ __forceinline__ void sincos_big(float ang, float& s, float& c) {
    double rev = (double)ang * 0.15915494309189535; rev -= rint(rev); const float f = (float)rev;
    s = __builtin_amdgcn_sinf(f); c = __builtin_amdgcn_cosf(f);
}
__device__ __forceinline__ float rope_inv_freq(int i) { return exp2f(-(float)i * (13.287712379549449f / 16.f)); }

namespace pg8 {
constexpr int BM = 256, BK = 64, HALF = 128, HTB = HALF * BK * 2, STAGE_BYTES = 8 * HTB, NXCD = 8, WGM = 8;
__host__ __device__ __forceinline__ int lds_byte(int r, int c) { const int st = (r >> 4) * 2 + (c >> 5), rr = r & 15, cc = c & 31, ob = rr * 64 + cc * 2; return st * 1024 + (ob ^ (((ob >> 9) & 1) << 5)); }
__host__ __device__ __forceinline__ void stage_rc(int b, int& R, int& C) { const int st = b / 1024, sb = b % 1024, swz = sb ^ (((sb >> 9) & 1) << 5); R = (st >> 1) * 16 + swz / 64; C = (st & 1) * 32 + (swz % 64) / 2; }
__host__ __device__ __forceinline__ int perm32(int rho) { const int n = rho >> 4, i = rho & 15; return 8 * (i >> 2) + 4 * n + (i & 3); }
struct Unit { int pm, pn; };
struct Gemm { const bf16* A; const bf16* Bt; int lda, ldb, M, N, K; };
struct StaticOrder {
    int nM, nN, nwg, G, c;
    __device__ void init(int M, int N, int G_, int c_) { asm volatile("" : "+s"(c_)); nM = M / BM; nN = N / BM; nwg = nM * nN; G = G_; c = c_; }
    __device__ bool next(int i, Unit& u) const {
        const long L = (long)i * G + c; if (L >= nwg) return false;
        int wgid = (int)L; { const int q = nwg / NXCD, r = nwg % NXCD, xcd = wgid % NXCD, off = wgid / NXCD; wgid = (xcd < r ? xcd * (q + 1) : r * (q + 1) + (xcd - r) * q) + off; }
        const int nig = WGM * nN, gid = wgid / nig, fm = gid * WGM, gsz = (nM - fm) < WGM ? (nM - fm) : WGM;
        u.pm = fm + ((wgid % nig) % gsz); u.pn = (wgid % nig) / gsz; return true;
    }
};
template <class Epi>
__device__ __forceinline__ void gemm_phase(LAS unsigned char* lds, const Gemm g, const StaticOrder& S, const Epi& E) {
    int tid_ = threadIdx.x; asm volatile("" : "+v"(tid_));
    const int tid = tid_, wid = __builtin_amdgcn_readfirstlane(tid >> 6), lane = tid & 63, wr = wid >> 2, wc = wid & 3, fr = lane & 15, fq = lane >> 4;
    const int K = g.K, nt = K / BK;
    unsigned voffA[2], voffB[2];
#pragma unroll
    for (int i = 0; i < 2; ++i) { int R, C; stage_rc(tid * 16 + i * 8192, R, C); const int Rb = (R & ~31) + perm32(R & 31);
        voffA[i] = (unsigned)(R * g.lda + C) * 2u; voffB[i] = (unsigned)(Rb * g.ldb + C) * 2u; }
    const size_t kstep = (size_t)(BK * 2);
    const size_t hsA = (size_t)HALF * g.lda * 2, hsB = (size_t)HALF * g.ldb * 2;
    const size_t tsA = 2 * hsA, tsB = 2 * hsB;
    const unsigned ldsw = (unsigned)wid * 1024u;
    const int aoff = lds_byte(wr * 64 + fr, fq * 8), boff = lds_byte(wc * 32 + fr, fq * 8);
#define PG8_SA(b, h) (((b) * 2 + (h)) * HTB)
#define PG8_SB(b, h) ((4 + (b) * 2 + (h)) * HTB)
#define PG8_STAGE(bufoff, gbase, voff) do { _Pragma("unroll") for (int _i = 0; _i < 2; ++_i) \
        __builtin_amdgcn_global_load_lds((const unsigned*)((const char*)(gbase) + (voff)[_i]), (LAS unsigned*)(lds + (bufoff) + ldsw + _i * 8192), 16, 0, 0); } while (0)
#define PG8_LDA(dst, b, h) do { _Pragma("unroll") for (int m = 0; m < 4; ++m) _Pragma("unroll") for (int k = 0; k < 2; ++k) dst[m][k] = *(const LAS bf16x8*)(lds + PG8_SA(b, h) + aoff + m * 2048 + k * 1024); } while (0)
#define PG8_LDB(dst, b, h) do { _Pragma("unroll") for (int n = 0; n < 2; ++n) _Pragma("unroll") for (int k = 0; k < 2; ++k) dst[n][k] = *(const LAS bf16x8*)(lds + PG8_SB(b, h) + boff + n * 2048 + k * 1024); } while (0)
#define PG8_MMA(ai, bj, At, Bt) do { __builtin_amdgcn_s_setprio(1); _Pragma("unroll") for (int m = 0; m < 4; ++m) _Pragma("unroll") for (int n = 0; n < 2; ++n) _Pragma("unroll") for (int k = 0; k < 2; ++k) \
        acc[ai][bj][m][n] = __builtin_amdgcn_mfma_f32_16x16x32_bf16(Bt[n][k], At[m][k], acc[ai][bj][m][n], 0, 0, 0); __builtin_amdgcn_s_setprio(0); } while (0)
#define PG8_WAIT_V(n) asm volatile("s_waitcnt vmcnt(" #n ")" ::: "memory")
#define PG8_WAIT_L(n) asm volatile("s_waitcnt lgkmcnt(" #n ")" ::: "memory")
#define PG8_BAR __builtin_amdgcn_s_barrier()
#define PG8_SCHED __builtin_amdgcn_sched_barrier(0)
    Unit cur, nxt; int ui = 0;
    if (!S.next(0, cur)) return;
    f32x4 acc[2][2][4][2];
#pragma unroll
    for (int a = 0; a < 2; ++a)
#pragma unroll
        for (int b = 0; b < 2; ++b)
#pragma unroll
            for (int m = 0; m < 4; ++m)
#pragma unroll
                for (int n = 0; n < 2; ++n) acc[a][b][m][n] = (f32x4){0.f, 0.f, 0.f, 0.f};
    bf16x8 At[4][2], B0[2][2], B1[2][2];
    const char* cA = (const char*)g.A + (size_t)cur.pm * tsA; const char* cB = (const char*)g.Bt + (size_t)cur.pn * tsB;
    PG8_STAGE(PG8_SB(0, 0), cB, voffB); PG8_STAGE(PG8_SB(0, 1), cB + hsB, voffB); PG8_STAGE(PG8_SA(0, 0), cA, voffA); PG8_STAGE(PG8_SA(0, 1), cA + hsA, voffA);
    if (wr == 1) PG8_BAR;
    PG8_WAIT_V(2); PG8_BAR;
    PG8_STAGE(PG8_SB(1, 0), cB + kstep, voffB); PG8_STAGE(PG8_SA(1, 0), cA + kstep, voffA); PG8_STAGE(PG8_SB(1, 1), cB + hsB + kstep, voffB);
    PG8_WAIT_V(6); PG8_BAR;
    for (;;) {
        const bool has_next = S.next(ui + 1, nxt);
        const char* nA = has_next ? (const char*)g.A + (size_t)nxt.pm * tsA : cA; const char* nB = has_next ? (const char*)g.Bt + (size_t)nxt.pn * tsB : cB;
#pragma unroll 1
        for (int t = 0; t < nt; t += 2) {
            const bool last = (t == nt - 2);
            const char* a1 = cA + (size_t)(t + 1) * kstep;
            const char* a2 = last ? nA : cA + (size_t)(t + 2) * kstep; const char* b2 = last ? nB : cB + (size_t)(t + 2) * kstep;
            const char* a3 = a2 + kstep; const char* b3 = b2 + kstep;
            PG8_LDB(B0, 0, 0); PG8_LDB(B1, 0, 1); PG8_SCHED; PG8_LDA(At, 0, 0); PG8_STAGE(PG8_SA(1, 1), a1 + hsA, voffA);
            PG8_WAIT_V(8); PG8_WAIT_L(0); PG8_BAR; PG8_MMA(0, 0, At, B0); PG8_MMA(0, 1, At, B1); PG8_BAR; PG8_SCHED;
            PG8_LDA(At, 0, 1); PG8_STAGE(PG8_SB(0, 0), b2, voffB); PG8_STAGE(PG8_SB(0, 1), b2 + hsB, voffB); PG8_STAGE(PG8_SA(0, 0), a2, voffA);
            PG8_WAIT_V(8); PG8_WAIT_L(0); PG8_BAR; PG8_MMA(1, 0, At, B0); PG8_MMA(1, 1, At, B1); PG8_BAR; PG8_SCHED;
            PG8_LDB(B0, 1, 0); PG8_LDB(B1, 1, 1); PG8_SCHED; PG8_LDA(At, 1, 0); PG8_STAGE(PG8_SA(0, 1), a2 + hsA, voffA);
            PG8_WAIT_V(8); PG8_WAIT_L(0); PG8_BAR; PG8_MMA(0, 0, At, B0); PG8_MMA(0, 1, At, B1); PG8_BAR; PG8_SCHED;
            PG8_LDA(At, 1, 1); PG8_STAGE(PG8_SB(1, 0), b3, voffB); PG8_STAGE(PG8_SB(1, 1), b3 + hsB, voffB); PG8_STAGE(PG8_SA(1, 0), a3, voffA);
            PG8_WAIT_V(8); PG8_WAIT_L(0); PG8_BAR; PG8_MMA(1, 0, At, B0); PG8_MMA(1, 1, At, B1); PG8_BAR; PG8_SCHED;
        }
        if (wr == 0) PG8_BAR;
        E(acc, cur, wr, wc, fr, fq);
        if (!has_next) break;
        PG8_WAIT_V(0);
#pragma unroll
        for (int a = 0; a < 2; ++a)
#pragma unroll
            for (int b = 0; b < 2; ++b)
#pragma unroll
                for (int m = 0; m < 4; ++m)
#pragma unroll
                    for (int n = 0; n < 2; ++n) acc[a][b][m][n] = (f32x4){0.f, 0.f, 0.f, 0.f};
        cur = nxt; cA = nA; cB = nB; ++ui;
        if (wr == 1) PG8_BAR;
    }
    PG8_WAIT_V(0);
    PG8_BAR;
#undef PG8_SA
#undef PG8_SB
#undef PG8_STAGE
#undef PG8_LDA
#undef PG8_LDB
#undef PG8_MMA
#undef PG8_WAIT_V
#undef PG8_WAIT_L
#undef PG8_BAR
#undef PG8_SCHED
}

typedef const f32x4 (&AccRef)[2][2][4][2];
struct EpiSwiglu {
    bf16* H; const float* ssq;
    __device__ __forceinline__ void operator()(AccRef acc, const Unit& u, int wr, int wc, int fr, int fq) const {
        const int row0 = u.pm * BM + wr * 64 + fr, col0 = u.pn * HALF + wc * 32 + 8 * fq;
        f32x4 qv[2][4];
#pragma unroll
        for (int ai = 0; ai < 2; ++ai)
#pragma unroll
            for (int m = 0; m < 4; ++m) qv[ai][m] = *(const f32x4*)(ssq + (size_t)(row0 + ai * HALF + m * 16) * 16 + fq * 4);
#pragma unroll
        for (int ai = 0; ai < 2; ++ai)
#pragma unroll
            for (int m = 0; m < 4; ++m) { const int r = row0 + ai * HALF + m * 16; const float rs = rsqrtf(quarter_sum(qv[ai][m]) * (1.f / DM) + EPS);
                float o[8];
#pragma unroll
                for (int n = 0; n < 2; ++n) { const f32x4 gv = acc[ai][0][m][n] * rs, uv = acc[ai][1][m][n] * rs;
#pragma unroll
                    for (int i = 0; i < 4; ++i) o[n * 4 + i] = gv[i] * sigmoidf_(gv[i]) * uv[i]; }
                u32x4 w; w.x = cvt_pk_bf16(o[0], o[1]); w.y = cvt_pk_bf16(o[2], o[3]); w.z = cvt_pk_bf16(o[4], o[5]); w.w = cvt_pk_bf16(o[6], o[7]);
                *(u32x4*)(H + (size_t)r * FF + col0) = w; }
    }
};
struct EpiRes {
    const float* xin; float* xout; bf16* xb; float* ssq_out; float scale;
    __device__ __forceinline__ void operator()(AccRef acc, const Unit& u, int wr, int wc, int fr, int fq) const {
        const int row0 = u.pm * BM + wr * 64 + fr, col0 = u.pn * BM + wc * 32 + 8 * fq;
#pragma unroll
        for (int ai = 0; ai < 2; ++ai) {
            f32x4 xv[4][2][2];
#pragma unroll
            for (int m = 0; m < 4; ++m)
#pragma unroll
                for (int bj = 0; bj < 2; ++bj) { const size_t o = (size_t)(row0 + ai * HALF + m * 16) * DM + col0 + bj * HALF;
                    xv[m][bj][0] = *(const f32x4*)(xin + o); xv[m][bj][1] = *(const f32x4*)(xin + o + 4); }
            __builtin_amdgcn_sched_barrier(0);
#pragma unroll
            for (int m = 0; m < 4; ++m) { const int r = row0 + ai * HALF + m * 16; float part = 0.f;
#pragma unroll
                for (int bj = 0; bj < 2; ++bj) { const size_t o = (size_t)r * DM + col0 + bj * HALF;
                    const f32x4 x0 = xv[m][bj][0] + acc[ai][bj][m][0] * scale, x1 = xv[m][bj][1] + acc[ai][bj][m][1] * scale;
                    *(f32x4*)(xout + o) = x0; *(f32x4*)(xout + o + 4) = x1;
                    if (xb) { u32x4 w; w.x = cvt_pk_bf16(x0[0], x0[1]); w.y = cvt_pk_bf16(x0[2], x0[3]); w.z = cvt_pk_bf16(x1[0], x1[1]); w.w = cvt_pk_bf16(x1[2], x1[3]);
                        *(u32x4*)(xb + o) = w; }
                    part += (x0[0] * x0[0] + x0[1] * x0[1]) + (x0[2] * x0[2] + x0[3] * x0[3]) + (x1[0] * x1[0] + x1[1] * x1[1]) + (x1[2] * x1[2] + x1[3] * x1[3]); }
                part += __shfl_xor(part, 16); part += __shfl_xor(part, 32);
                if (fq == 0 && xb) ssq_out[(size_t)r * 16 + u.pn * 4 + wc] = part; }
        }
    }
};
struct EpiU {
    bf16* U; int ldu; const float* ssqx; float* ssq_cq; float* ssq_ckv; int mla;
    __device__ __forceinline__ void operator()(AccRef acc, const Unit& u, int wr, int wc, int fr, int fq) const {
        const int row0 = u.pm * BM + wr * 64 + fr, col0 = u.pn * BM + wc * 32 + 8 * fq;
        f32x4 qv[2][4];
#pragma unroll
        for (int ai = 0; ai < 2; ++ai)
#pragma unroll
            for (int m = 0; m < 4; ++m) qv[ai][m] = *(const f32x4*)(ssqx + (size_t)(row0 + ai * HALF + m * 16) * 16 + fq * 4);
#pragma unroll
        for (int ai = 0; ai < 2; ++ai)
#pragma unroll
            for (int m = 0; m < 4; ++m) { const int r = row0 + ai * HALF + m * 16; const float rs = rsqrtf(quarter_sum(qv[ai][m]) * (1.f / DM) + EPS); float pq = 0.f, pk = 0.f;
#pragma unroll
                for (int bj = 0; bj < 2; ++bj) { const f32x4 v0 = acc[ai][bj][m][0] * rs, v1 = acc[ai][bj][m][1] * rs;
                    u32x4 w; w.x = cvt_pk_bf16(v0[0], v0[1]); w.y = cvt_pk_bf16(v0[2], v0[3]); w.z = cvt_pk_bf16(v1[0], v1[1]); w.w = cvt_pk_bf16(v1[2], v1[3]);
                    *(u32x4*)(U + (size_t)r * ldu + col0 + bj * HALF) = w;
                    if (mla) { const float s = (v0[0] * v0[0] + v0[1] * v0[1]) + (v0[2] * v0[2] + v0[3] * v0[3]) + (v1[0] * v1[0] + v1[1] * v1[1]) + (v1[2] * v1[2] + v1[3] * v1[3]);
                        const int cc = u.pn * 2 + bj; if (cc < 3) pq += s; else if (cc < 5) pk += s; } }
                if (mla && u.pn < 3) { pq += __shfl_xor(pq, 16); pq += __shfl_xor(pq, 32); pk += __shfl_xor(pk, 16); pk += __shfl_xor(pk, 32);
                    if (fq == 0) { if (u.pn < 2) ssq_cq[(size_t)r * 8 + u.pn * 4 + wc] = pq; if (u.pn > 0) ssq_ckv[(size_t)r * 8 + (u.pn - 1) * 4 + wc] = pk; } } }
    }
};
struct EpiRowScale {
    bf16* O; int ldo, ncols; const float* ssq; float inv_dim;
    __device__ __forceinline__ void operator()(AccRef acc, const Unit& u, int wr, int wc, int fr, int fq) const {
        const int row0 = u.pm * BM + wr * 64 + fr, col0 = u.pn * BM + wc * 32 + 8 * fq;
#pragma unroll
        for (int ai = 0; ai < 2; ++ai)
#pragma unroll
            for (int m = 0; m < 4; ++m) { const int r = row0 + ai * HALF + m * 16; const float rs = rsqrtf(sum8(ssq + (size_t)r * 8) * inv_dim + EPS);
#pragma unroll
                for (int bj = 0; bj < 2; ++bj) { const int c = col0 + bj * HALF; if (c < ncols) { const f32x4 v0 = acc[ai][bj][m][0] * rs, v1 = acc[ai][bj][m][1] * rs;
                    u32x4 w; w.x = cvt_pk_bf16(v0[0], v0[1]); w.y = cvt_pk_bf16(v0[2], v0[3]); w.z = cvt_pk_bf16(v1[0], v1[1]); w.w = cvt_pk_bf16(v1[2], v1[3]);
                    *(u32x4*)(O + (size_t)r * ldo + c) = w; } } }
    }
};
struct EpiVt {
    bf16* Vt; const float* ssq;
    __device__ __forceinline__ void operator()(AccRef acc, const Unit& u, int wr, int wc, int fr, int fq) const {
        const int row0 = u.pm * BM + wr * 64 + fr, col0 = u.pn * BM + wc * 32 + 8 * fq;
#pragma unroll
        for (int bj = 0; bj < 2; ++bj) { const int c = col0 + bj * HALF;
            f32x4 s0, s1;
#pragma unroll
            for (int i = 0; i < 4; ++i) { s0[i] = rsqrtf(sum8(ssq + (size_t)(c + i) * 8) * (1.f / KVL) + EPS); s1[i] = rsqrtf(sum8(ssq + (size_t)(c + 4 + i) * 8) * (1.f / KVL) + EPS); }
            const int b = c >> 14, s = c & (SEQ - 1);
#pragma unroll
            for (int ai = 0; ai < 2; ++ai)
#pragma unroll
                for (int m = 0; m < 4; ++m) { const int r = row0 + ai * HALF + m * 16; const f32x4 v0 = acc[ai][bj][m][0] * s0, v1 = acc[ai][bj][m][1] * s1;
                    u32x4 w; w.x = cvt_pk_bf16(v0[0], v0[1]); w.y = cvt_pk_bf16(v0[2], v0[3]); w.z = cvt_pk_bf16(v1[0], v1[1]); w.w = cvt_pk_bf16(v1[2], v1[3]);
                    *(u32x4*)(Vt + ((((size_t)(b * NH + (r >> 6)) * (SEQ / 64) + (s >> 6)) * 64 + (r & 63)) * 64 + (s & 63))) = w; } }
    }
};
struct EpiMemKV {
    float* O; const float* ssq;
    __device__ __forceinline__ void operator()(AccRef acc, const Unit& u, int wr, int wc, int fr, int fq) const {
        const int row0 = u.pm * BM + wr * 64 + fr, col0 = u.pn * BM + wc * 32 + 8 * fq;
#pragma unroll
        for (int ai = 0; ai < 2; ++ai)
#pragma unroll
            for (int m = 0; m < 4; ++m) { const int r = row0 + ai * HALF + m * 16; const float rs = rsqrtf(ssq[r] * (1.f / DM) + EPS);
#pragma unroll
                for (int bj = 0; bj < 2; ++bj) { float* o = O + (size_t)r * 2048 + col0 + bj * HALF;
                    *(f32x4*)o = acc[ai][bj][m][0] * rs; *(f32x4*)(o + 4) = acc[ai][bj][m][1] * rs; } }
    }
};
}

__device__ __forceinline__ int rowmap(int mode, int n) {
    if (mode == 1) { const int hi = n >= FF, m = hi ? n - FF : n; return (m >> 7) * 256 + (hi ? 128 : 0) + (m & 127); }
    if (mode == 2) { const int h = n >> 7, r = n & 127; return (r < 64 ? 0 : 768) + h * 64 + (r & 63); }
    return n;
}
__device__ __forceinline__ void transpose_item(const float* __restrict__ W, int K, int N, const float* __restrict__ gain, bf16* WT, int mode, LAS float* scr, int item, int lane) {
    const int nblk = N / 32, kb = item / nblk, nb = item % nblk, k0 = 64 * kb, n0 = 32 * nb;
#pragma unroll
    for (int i = 0; i < 8; ++i) { const int kk = 8 * i + (lane >> 3), n4 = (lane & 7) * 4;
        f32x4 v = *(const f32x4*)(W + (size_t)(k0 + kk) * N + n0 + n4); if (gain) v = v * gain[k0 + kk];
        LAS float* d = scr + kk * 33 + n4; d[0] = v[0]; d[1] = v[1]; d[2] = v[2]; d[3] = v[3]; }
    asm volatile("s_waitcnt lgkmcnt(0)" ::: "memory");
    const int c = lane & 7;
#pragma unroll
    for (int j = 0; j < 4; ++j) { const int n = (lane >> 3) + 8 * j; const LAS float* s = scr + (8 * c) * 33 + n;
        u32x4 o; o.x = cvt_pk_bf16(s[0 * 33], s[1 * 33]); o.y = cvt_pk_bf16(s[2 * 33], s[3 * 33]); o.z = cvt_pk_bf16(s[4 * 33], s[5 * 33]); o.w = cvt_pk_bf16(s[6 * 33], s[7 * 33]);
        *(u32x4*)(WT + (size_t)rowmap(mode, n0 + n) * K + k0 + 8 * c) = o; }
    asm volatile("s_waitcnt lgkmcnt(0)" ::: "memory");
}
#define TJOB(W, K, N, GAIN, WT, MODE) do { const int _ni = ((K) / 64) * ((N) / 32); for (; it < _ni; it += 2 * NGW) { transpose_item((W), (K), (N), (GAIN), (WT), (MODE), scr, it, lane); if (it + NGW < _ni) transpose_item((W), (K), (N), (GAIN), (WT), (MODE), scr + 2112, it + NGW, lane); } if (it - NGW >= _ni) it -= NGW; it -= _ni; } while (0)

__device__ __forceinline__ void row_to_bf16_ssq(const float* xrow, bf16* orow, float* ssq_out, int nslots, int lane) {
    const f32x4* xr = (const f32x4*)xrow + lane; f32x4 v[4]; float s = 0.f;
#pragma unroll
    for (int j = 0; j < 4; ++j) { v[j] = xr[64 * j]; s += (v[j][0] * v[j][0] + v[j][1] * v[j][1]) + (v[j][2] * v[j][2] + v[j][3] * v[j][3]); }
    s = wave_sum(s);
    u32x2* o8 = (u32x2*)orow + lane;
#pragma unroll
    for (int j = 0; j < 4; ++j) { u32x2 w; w.x = cvt_pk_bf16(v[j][0], v[j][1]); w.y = cvt_pk_bf16(v[j][2], v[j][3]); o8[64 * j] = w; }
    if (lane < nslots) ssq_out[lane] = lane == 0 ? s : 0.f;
}

template <int D, bool ROPE, bool FIXED>
__device__ __forceinline__ void attn_core(LAS unsigned char* lds, const bf16* __restrict__ Q, int ldq, int qtok0, const float* __restrict__ qgain, const int* __restrict__ positions,
                                          const bf16* __restrict__ Kp, const bf16* __restrict__ Vt, int nkeys, bf16* O, int ldo, float qscale, float negb) {
    constexpr int NKS = D / 16, KSTR = D * 2 + 16, VSTR = 144, KBUF = 64 * KSTR, VBUF = 64 * VSTR, KCH = 64 * D * 2 / 16;
    int tid_ = threadIdx.x; asm volatile("" : "+v"(tid_));
    const int tid = tid_, wave = tid >> 6, lane = tid & 63, r32 = lane & 31, h = lane >> 5;
    constexpr int TBUF = KBUF + VBUF;
    const int kc0 = tid, kc1 = tid + 512;
    const bool has1 = kc1 < KCH;
    const int kl0 = (kc0 / (D / 8)) * KSTR + (kc0 % (D / 8)) * 16, kl1 = (kc1 / (D / 8)) * KSTR + (kc1 % (D / 8)) * 16;
    const int vdv = tid >> 3, vpart = tid & 7, vl = KBUF + vdv * VSTR + (vpart >> 1) * 32 + (vpart & 1) * 8;
    const bf16* vsrc = Vt + (size_t)vdv * 64 + vpart * 8;
    const int nt = nkeys / 64;
    u32x4 krA0, krA1 = {0, 0, 0, 0}, vrA, krB0, krB1 = {0, 0, 0, 0}, vrB;
#define ATT_LOAD(tt, k0_, k1_, v_) do { const bf16* kp_ = Kp + (size_t)(tt) * 64 * D; k0_ = *(const u32x4*)(kp_ + (size_t)kc0 * 8); if (has1) k1_ = *(const u32x4*)(kp_ + (size_t)kc1 * 8); v_ = *(const u32x4*)(vsrc + (size_t)(tt) * 4096); } while (0)
#define ATT_STORE(boff, k0_, k1_, v_) do { LAS unsigned char* b_ = lds + (boff); *(LAS u32x4*)(b_ + kl0) = k0_; if (has1) *(LAS u32x4*)(b_ + kl1) = k1_; \
        *(LAS u32x2*)(b_ + vl) = (u32x2){v_.x, v_.y}; *(LAS u32x2*)(b_ + vl + 16) = (u32x2){v_.z, v_.w}; } while (0)
#define ATT_QK(boff, d0, d1) do { const LAS unsigned char* Kb_ = lds + (boff) + r32 * KSTR + h * 16; \
        _Pragma("unroll") for (int j_ = 0; j_ < 16; ++j_) { d0[j_] = FIXED ? negb : 0.f; d1[j_] = FIXED ? negb : 0.f; } \
        _Pragma("unroll") for (int ks_ = 0; ks_ < NKS; ++ks_) { \
            const bf16x8 k0_ = *(const LAS bf16x8*)(Kb_ + ks_ * 32); const bf16x8 k1_ = *(const LAS bf16x8*)(Kb_ + 32 * KSTR + ks_ * 32); \
            d0 = __builtin_amdgcn_mfma_f32_32x32x16_bf16(k0_, qf[ks_], d0, 0, 0, 0); d1 = __builtin_amdgcn_mfma_f32_32x32x16_bf16(k1_, qf[ks_], d1, 0, 0, 0); } } while (0)
#define ATT_ITER(t, LK0, LK1, LV, SK0, SK1, SV) do { \
        { const int tn_ = ((t) + 3 < nt) ? (t) + 3 : nt - 1; ATT_LOAD(tn_, LK0, LK1, LV); } \
        f32x16 n0, n1; \
        __builtin_amdgcn_s_setprio(1); \
        ATT_QK(b1, n0, n1); \
        if constexpr (FIXED) {   \
            float ps = 0.f; \
            _Pragma("unroll") for (int j = 0; j < 16; ++j) { s0[j] = __builtin_amdgcn_exp2f(s0[j]); s1[j] = __builtin_amdgcn_exp2f(s1[j]); ps += s0[j] + s1[j]; } \
            lsum += ps; \
        } else { \
            float mx = fmaxf(s0[0], s1[0]); \
            _Pragma("unroll") for (int j = 1; j < 16; ++j) mx = fmaxf(mx, fmaxf(s0[j], s1[j])); \
            mx = fmaxf(mx, __shfl_xor(mx, 32)); \
            const float mnew = fmaxf(mrow, mx), alpha = __builtin_amdgcn_exp2f(mrow - mnew); mrow = mnew; \
            float ps = 0.f; \
            _Pragma("unroll") for (int j = 0; j < 16; ++j) { s0[j] = __builtin_amdgcn_exp2f(s0[j] - mnew); s1[j] = __builtin_amdgcn_exp2f(s1[j] - mnew); ps += s0[j] + s1[j]; } \
            lsum = lsum * alpha + ps; \
            _Pragma("unroll") for (int j = 0; j < 16; ++j) { o0[j] *= alpha; o1[j] *= alpha; } \
        } \
        bf16x8 p[4]; \
        { u32x4 w; \
          w.x = cvt_pk_bf16(s0[0], s0[1]); w.y = cvt_pk_bf16(s0[2], s0[3]); w.z = cvt_pk_bf16(s0[4], s0[5]); w.w = cvt_pk_bf16(s0[6], s0[7]); p[0] = __builtin_bit_cast(bf16x8, w); \
          w.x = cvt_pk_bf16(s0[8], s0[9]); w.y = cvt_pk_bf16(s0[10], s0[11]); w.z = cvt_pk_bf16(s0[12], s0[13]); w.w = cvt_pk_bf16(s0[14], s0[15]); p[1] = __builtin_bit_cast(bf16x8, w); \
          w.x = cvt_pk_bf16(s1[0], s1[1]); w.y = cvt_pk_bf16(s1[2], s1[3]); w.z = cvt_pk_bf16(s1[4], s1[5]); w.w = cvt_pk_bf16(s1[6], s1[7]); p[2] = __builtin_bit_cast(bf16x8, w); \
          w.x = cvt_pk_bf16(s1[8], s1[9]); w.y = cvt_pk_bf16(s1[10], s1[11]); w.z = cvt_pk_bf16(s1[12], s1[13]); w.w = cvt_pk_bf16(s1[14], s1[15]); p[3] = __builtin_bit_cast(bf16x8, w); } \
        const LAS unsigned char* Vb = lds + b0 + KBUF + r32 * VSTR + h * 16; \
        _Pragma("unroll") for (int kk = 0; kk < 4; ++kk) { \
            const bf16x8 vf0 = *(const LAS bf16x8*)(Vb + kk * 32); \
            const bf16x8 vf1 = *(const LAS bf16x8*)(Vb + 32 * VSTR + kk * 32); \
            o0 = __builtin_amdgcn_mfma_f32_32x32x16_bf16(vf0, p[kk], o0, 0, 0, 0); \
            o1 = __builtin_amdgcn_mfma_f32_32x32x16_bf16(vf1, p[kk], o1, 0, 0, 0); \
        } \
        __builtin_amdgcn_s_setprio(0); \
        ATT_STORE(b2, SK0, SK1, SV); \
        s0 = n0; s1 = n1; \
        { const int tmp = b0; b0 = b1; b1 = b2; b2 = tmp; } \
        __syncthreads(); \
    } while (0)
    ATT_LOAD(0, krA0, krA1, vrA);
    ATT_LOAD(1, krB0, krB1, vrB);
    bf16x8 qf[NKS];
    {
        const int qtok = qtok0 + wave * 32 + r32;
        float v[NKS][8]; float ss = 0.f;
#pragma unroll
        for (int ks = 0; ks < NKS; ++ks) { const u32x4 raw = *(const u32x4*)(Q + (size_t)qtok * ldq + ks * 16 + h * 8);
            v[ks][0] = bflo(raw.x); v[ks][1] = bfhi(raw.x); v[ks][2] = bflo(raw.y); v[ks][3] = bfhi(raw.y); v[ks][4] = bflo(raw.z); v[ks][5] = bfhi(raw.z); v[ks][6] = bflo(raw.w); v[ks][7] = bfhi(raw.w);
#pragma unroll
            for (int j = 0; j < 8; ++j) ss += v[ks][j] * v[ks][j]; }
        ss += __shfl_xor(ss, 32);
        const float rs = rsqrtf(ss * (1.f / D) + EPS);
#pragma unroll
        for (int ks = 0; ks < NKS; ++ks)
#pragma unroll
            for (int j = 0; j < 8; ++j) v[ks][j] *= rs * qgain[ks * 16 + h * 8 + j];
        if constexpr (ROPE) {
            const float pos = (float)positions[qtok];
#pragma unroll
            for (int j = 0; j < 8; ++j) { float s, c; sincos_big(pos * rope_inv_freq(h * 8 + j), s, c);
                const float x1 = v[4][j], x2 = v[5][j]; v[4][j] = x1 * c - x2 * s; v[5][j] = x2 * c + x1 * s; }
        }
#pragma unroll
        for (int ks = 0; ks < NKS; ++ks) { u32x4 w; w.x = cvt_pk_bf16(v[ks][0] * qscale, v[ks][1] * qscale); w.y = cvt_pk_bf16(v[ks][2] * qscale, v[ks][3] * qscale);
            w.z = cvt_pk_bf16(v[ks][4] * qscale, v[ks][5] * qscale); w.w = cvt_pk_bf16(v[ks][6] * qscale, v[ks][7] * qscale); qf[ks] = __builtin_bit_cast(bf16x8, w); }
    }
    __syncthreads();
    ATT_STORE(0, krA0, krA1, vrA);
    ATT_STORE(TBUF, krB0, krB1, vrB);
    { const int t2 = nt > 2 ? 2 : nt - 1; ATT_LOAD(t2, krB0, krB1, vrB); }
    __syncthreads();
    f32x16 o0, o1, s0, s1;
#pragma unroll
    for (int j = 0; j < 16; ++j) { o0[j] = 0.f; o1[j] = 0.f; }
    float mrow = -1e30f, lsum = 0.f;
    int b0 = 0, b1 = TBUF, b2 = 2 * TBUF;
    ATT_QK(b0, s0, s1);
    for (int t = 0; t < nt; t += 2) {
        ATT_ITER(t, krA0, krA1, vrA, krB0, krB1, vrB);
        ATT_ITER(t + 1, krB0, krB1, vrB, krA0, krA1, vrA);
    }
#undef ATT_ITER
#undef ATT_LOAD
#undef ATT_STORE
#undef ATT_QK
    lsum += __shfl_xor(lsum, 32);
    const float inv = 1.f / lsum;
    bf16* orow = O + (size_t)(qtok0 + wave * 32 + r32) * ldo;
#pragma unroll
    for (int g4 = 0; g4 < 4; ++g4) {
        u32x2 w; w.x = cvt_pk_bf16(o0[g4 * 4 + 0] * inv, o0[g4 * 4 + 1] * inv); w.y = cvt_pk_bf16(o0[g4 * 4 + 2] * inv, o0[g4 * 4 + 3] * inv);
        *(u32x2*)(orow + g4 * 8 + h * 4) = w;
        w.x = cvt_pk_bf16(o1[g4 * 4 + 0] * inv, o1[g4 * 4 + 1] * inv); w.y = cvt_pk_bf16(o1[g4 * 4 + 2] * inv, o1[g4 * 4 + 3] * inv);
        *(u32x2*)(orow + 32 + g4 * 8 + h * 4) = w;
    }
}

template <int D, bool ROPE>
__device__ __forceinline__ void attn_unit(LAS unsigned char* lds, const bf16* __restrict__ Q, int ldq, int qtok0, const float* __restrict__ qgain, const float* __restrict__ kgain, const int* __restrict__ positions,
                                          const bf16* __restrict__ Kp, const bf16* __restrict__ Vt, int nkeys, bf16* O, int ldo, float qscale) {
    float mq = 0.f, mk = 0.f;
    for (int i = 0; i < D; ++i) { mq = fmaxf(mq, fabsf(qgain[i])); mk = fmaxf(mk, fabsf(kgain[i])); }
    const float B = mq * mk * (float)D * qscale * 1.03f + 0.5f;
    if (B < 48.f) attn_core<D, ROPE, true>(lds, Q, ldq, qtok0, qgain, positions, Kp, Vt, nkeys, O, ldo, qscale, -B);
    else attn_core<D, ROPE, false>(lds, Q, ldq, qtok0, qgain, positions, Kp, Vt, nkeys, O, ldo, qscale, 0.f);
}

__device__ __forceinline__ int lds_byte3(int r, int c) { const int st = (r >> 4) * 3 + (c >> 5), rr = r & 15, cc = c & 31, ob = rr * 64 + cc * 2; return st * 1024 + (ob ^ (((ob >> 9) & 1) << 5)); }
__device__ __forceinline__ float gelu_tanh(float x) { const float z = x * (1.5957691216057308f + 0.07135481627260025f * x * x); return x * __builtin_amdgcn_rcpf(1.f + __builtin_amdgcn_exp2f(-1.4426950408889634f * z)); }
constexpr int LRU_XCB = 0, LRU_XCF = 12288, LRU_AB = 36864;
constexpr int LRU_CST = 135168;
__device__ __forceinline__ void lru_load_consts(LAS unsigned char* lds, int n, const float* __restrict__ conv_w, const float* __restrict__ conv_b, const float* __restrict__ gate_b, const float* __restrict__ sp) {
    int tid_ = threadIdx.x; asm volatile("" : "+v"(tid_));
    LAS float* C = (LAS float*)(lds + LRU_CST);
    for (int i = tid_; i < 1056; i += NTHR) { float v;
        if (i < 384) v = conv_w[(i / 96) * LRUW + n * 96 + i % 96];
        else if (i < 480) v = conv_b[n * 96 + (i - 384)];
        else if (i < 864) v = gate_b[((i - 480) / 96) * LRUW + n * 96 + (i - 480) % 96];
        else v = sp[((i - 864) / 96) * LRUW + n * 96 + (i - 864) % 96];
        C[i] = v; }
}
template <bool FINAL>
__device__ __forceinline__ void lru_item(LAS unsigned char* lds, int item, const bf16* __restrict__ U, const float* __restrict__ conv_w, const float* __restrict__ conv_b,
                                         const bf16* __restrict__ WgT, const float* __restrict__ gate_b, const float* __restrict__ lam,
                                         float* Pbuf, float* Hend, const float* __restrict__ carry, bf16* MIX) {
    int tid_ = threadIdx.x; asm volatile("" : "+v"(tid_));
    const int tid = tid_, wave = tid >> 6, lane = tid & 63;
    const int n = item & 7, c = (item >> 3) & 255, b = item >> 11, t0 = c * 64;
    LAS unsigned char* XCB = lds + LRU_XCB; LAS float* XCF = (LAS float*)(lds + LRU_XCF); LAS float* AB = (LAS float*)(lds + LRU_AB); const LAS float* CST = (const LAS float*)(lds + LRU_CST);
    for (int task = tid; task < 768; task += NTHR) {
        const int t = task / 12, c8 = (task % 12) * 8, gc = n * 96 + c8;
        float acc[8];
        { const f32x4 b0 = *(const LAS f32x4*)(CST + 384 + c8), b1 = *(const LAS f32x4*)(CST + 384 + c8 + 4);
          acc[0] = b0[0]; acc[1] = b0[1]; acc[2] = b0[2]; acc[3] = b0[3]; acc[4] = b1[0]; acc[5] = b1[1]; acc[6] = b1[2]; acc[7] = b1[3]; }
#pragma unroll
        for (int j = 0; j < 4; ++j) { const int s = t0 + t + j - 2;
            if (s >= 0 && s < SEQ) { const u32x4 raw = *(const u32x4*)(U + (size_t)(b * SEQ + s) * LRU_IN + LRUW + gc);
                const f32x4 w0 = *(const LAS f32x4*)(CST + j * 96 + c8), w1 = *(const LAS f32x4*)(CST + j * 96 + c8 + 4);
                acc[0] += w0[0] * bflo(raw.x); acc[1] += w0[1] * bfhi(raw.x); acc[2] += w0[2] * bflo(raw.y); acc[3] += w0[3] * bfhi(raw.y);
                acc[4] += w1[0] * bflo(raw.z); acc[5] += w1[1] * bfhi(raw.z); acc[6] += w1[2] * bflo(raw.w); acc[7] += w1[3] * bfhi(raw.w); } }
        *(LAS f32x4*)(XCF + t * 96 + c8) = (f32x4){acc[0], acc[1], acc[2], acc[3]}; *(LAS f32x4*)(XCF + t * 96 + c8 + 4) = (f32x4){acc[4], acc[5], acc[6], acc[7]};
        u32x4 w; w.x = cvt_pk_bf16(acc[0], acc[1]); w.y = cvt_pk_bf16(acc[2], acc[3]); w.z = cvt_pk_bf16(acc[4], acc[5]); w.w = cvt_pk_bf16(acc[6], acc[7]);
        *(LAS u32x4*)(XCB + lds_byte3(t, c8)) = w;
    }
    __syncthreads();
    {
        const int dir = wave & 1, mp = (wave >> 1) & 1, nh = wave >> 2, fr = lane & 15, fq = lane >> 4;
        bf16x8 af[2][3];
#pragma unroll
        for (int mm = 0; mm < 2; ++mm)
#pragma unroll
            for (int ks = 0; ks < 3; ++ks) af[mm][ks] = *(const LAS bf16x8*)(XCB + lds_byte3((mp * 2 + mm) * 16 + fr, ks * 32 + fq * 8));
        f32x4 acc[2][3][2];
#pragma unroll
        for (int g = 0; g < 2; ++g)
#pragma unroll
            for (int nl = 0; nl < 3; ++nl) { acc[g][nl][0] = (f32x4){0.f, 0.f, 0.f, 0.f}; acc[g][nl][1] = (f32x4){0.f, 0.f, 0.f, 0.f};
                const bf16* wp = WgT + ((size_t)(((dir * 2 + g) * 8 + n) * 96 + (nh * 3 + nl) * 16 + fr)) * 96 + fq * 8;
#pragma unroll
                for (int ks = 0; ks < 3; ++ks) { const bf16x8 bfr = *(const bf16x8*)(wp + ks * 32);
                    acc[g][nl][0] = __builtin_amdgcn_mfma_f32_16x16x32_bf16(af[0][ks], bfr, acc[g][nl][0], 0, 0, 0);
                    acc[g][nl][1] = __builtin_amdgcn_mfma_f32_16x16x32_bf16(af[1][ks], bfr, acc[g][nl][1], 0, 0, 0); } }
#pragma unroll
        for (int nl = 0; nl < 3; ++nl) { const int ch = (nh * 3 + nl) * 16 + fr, gc = n * 96 + ch;
            const float br = CST[480 + (dir * 2 + 0) * 96 + ch], bi = CST[480 + (dir * 2 + 1) * 96 + ch];
            const float sp = CST[864 + dir * 96 + ch];
#pragma unroll
            for (int mm = 0; mm < 2; ++mm)
#pragma unroll
            for (int i = 0; i < 4; ++i) { const int t = (mp * 2 + mm) * 16 + fq * 4 + i;
                const float r = sigmoidf_(acc[0][nl][mm][i] + br), ig = sigmoidf_(acc[1][nl][mm][i] + bi);
                const float la = -8.f * r * sp, a = __expf(la), x2 = 2.f * la;
                const float em1 = (x2 > -0.02f) ? x2 * (1.f + x2 * (0.5f + x2 * (1.f / 6.f))) : (a * a - 1.f);
                const float bb = __builtin_amdgcn_sqrtf(fmaxf(-em1, 0.f)) * ig * XCF[t * 96 + ch];
                *(LAS f32x2_t*)(AB + ((dir * 64 + t) * 96 + ch) * 2) = (f32x2_t){a, bb}; } }
    }
    __syncthreads();
    if (tid < 192) {
        const int dir = tid / 96, ch = tid % 96, gc = n * 96 + ch;
        const size_t cidx = ((size_t)((b * 2 + dir) * 256 + c)) * LRUW + gc;
        float hst = FINAL ? carry[cidx] : 0.f, P = 1.f;
        LAS float* Ab = AB + (dir * 64 * 96 + ch) * 2;
        for (int s8 = 0; s8 < 8; ++s8) {
            float av[8], bv[8];
#pragma unroll
            for (int j = 0; j < 8; ++j) { const int st = s8 * 8 + j, t = dir ? 63 - st : st; const f32x2_t ab = *(const LAS f32x2_t*)(Ab + t * 192); av[j] = ab[0]; bv[j] = ab[1]; }
#pragma unroll
            for (int j = 0; j < 8; ++j) { hst = av[j] * hst + bv[j]; if (FINAL) bv[j] = hst; else P *= av[j]; }
            if (FINAL) {
#pragma unroll
                for (int j = 0; j < 8; ++j) { const int st = s8 * 8 + j, t = dir ? 63 - st : st; Ab[t * 192 + 1] = bv[j]; } }
        }
        if (!FINAL) { Hend[cidx] = hst; Pbuf[cidx] = P; }
    }
    __syncthreads();
    if (FINAL) {
        for (int task = tid; task < 768; task += NTHR) {
            const int t = task / 12, c8 = (task % 12) * 8, gc = n * 96 + c8;
            const size_t tok = (size_t)(b * SEQ + t0 + t);
            const u32x4 raw = *(const u32x4*)(U + tok * LRU_IN + gc);
            const LAS float* h0 = AB + ((0 * 64 + t) * 96 + c8) * 2; const LAS float* h1 = AB + ((1 * 64 + t) * 96 + c8) * 2;
            const f32x4 p0 = *(const LAS f32x4*)h0, p1 = *(const LAS f32x4*)(h0 + 4), p2 = *(const LAS f32x4*)(h0 + 8), p3 = *(const LAS f32x4*)(h0 + 12);
            const f32x4 q0 = *(const LAS f32x4*)h1, q1 = *(const LAS f32x4*)(h1 + 4), q2 = *(const LAS f32x4*)(h1 + 8), q3 = *(const LAS f32x4*)(h1 + 12);
            float o[8];
            o[0] = (p0[1] + q0[1]) * gelu_tanh(bflo(raw.x)); o[1] = (p0[3] + q0[3]) * gelu_tanh(bfhi(raw.x));
            o[2] = (p1[1] + q1[1]) * gelu_tanh(bflo(raw.y)); o[3] = (p1[3] + q1[3]) * gelu_tanh(bfhi(raw.y));
            o[4] = (p2[1] + q2[1]) * gelu_tanh(bflo(raw.z)); o[5] = (p2[3] + q2[3]) * gelu_tanh(bfhi(raw.z));
            o[6] = (p3[1] + q3[1]) * gelu_tanh(bflo(raw.w)); o[7] = (p3[3] + q3[3]) * gelu_tanh(bfhi(raw.w));
            u32x4 w; w.x = cvt_pk_bf16(o[0], o[1]); w.y = cvt_pk_bf16(o[2], o[3]); w.z = cvt_pk_bf16(o[4], o[5]); w.w = cvt_pk_bf16(o[6], o[7]);
            *(u32x4*)(MIX + tok * DM + gc) = w;
        }
        __syncthreads();
    }
}


#define XB_TMO      128
#define XB_XCNT(j)  (256  + 64 * (j))
#define XB_XSUB(j)  (1280 + 64 * (j))
#define XB_XGEN(j)  (2304 + 64 * (j))
#define XB_TOP      3328
#define XB_TOPGEN   3392
#define XCD_BAR_WORDS 3456
#define XB_SPIN_CAP (1u << 20)
__device__ __forceinline__ unsigned xb_ld(unsigned* p)              { return __hip_atomic_load(p, __ATOMIC_RELAXED, __HIP_MEMORY_SCOPE_AGENT); }
__device__ __forceinline__ unsigned xb_add(unsigned* p, unsigned v) { return __hip_atomic_fetch_add(p, v, __ATOMIC_RELAXED, __HIP_MEMORY_SCOPE_AGENT); }
__device__ __forceinline__ unsigned xb_xcc_id() { return (unsigned)__builtin_amdgcn_s_getreg((3 << 11) | 20) & 0xFu; }
#define XB_SPIN(cond, bar) do { unsigned _sp = 0; while (cond) { __builtin_amdgcn_s_sleep(1); \
    if ((++_sp & 255u) == 0u) { if (xb_ld(&(bar)[XB_TMO])) break; if (_sp > XB_SPIN_CAP) { atomicAdd(&(bar)[XB_TMO], 1u); break; } } } } while (0)
__device__ __forceinline__ void xcd_barrier_complete(unsigned* bar, unsigned x, unsigned& nloc, unsigned& nx) {
    const unsigned G = gridDim.x * gridDim.y * gridDim.z;
    unsigned sum, cnt, mine, sp = 0u;
    for (;;) {
        sum = 0u; cnt = 0u; mine = 0u;
#pragma unroll
        for (unsigned j = 0; j < 16; ++j) { const unsigned c = xb_ld(&bar[XB_XCNT(j)]); sum += c; cnt += (c > 0u) ? 1u : 0u; mine = (j == x) ? c : mine; }
        if (sum == G) break;
        __builtin_amdgcn_s_sleep(1);
        if ((++sp & 255u) == 0u) { if (xb_ld(&bar[XB_TMO])) break; if (sp > XB_SPIN_CAP) { atomicAdd(&bar[XB_TMO], 1u); break; } }
    }
    nloc = mine > 0u ? mine : 1u; nx = cnt > 0u ? cnt : 1u;
}
__device__ __forceinline__ void xcd_barrier(unsigned* bar, volatile LAS unsigned* st) {
    asm volatile("s_waitcnt vmcnt(0)" ::: "memory");
    __syncthreads();
    if (threadIdx.x == 0) {
        const unsigned x = xb_xcc_id();
        __builtin_amdgcn_s_waitcnt(0);
        unsigned nloc = st[0], nx = st[1];
        if (nloc == 0u) { xcd_barrier_complete(bar, x, nloc, nx); st[0] = nloc; st[1] = nx; }
        const unsigned old = xb_add(&bar[XB_XSUB(x)], 1u);
        const unsigned gen = old / nloc;
        if (old + 1u == (gen + 1u) * nloc) {
            __builtin_amdgcn_fence(__ATOMIC_RELEASE, "agent");
            asm volatile("s_waitcnt vmcnt(0)" ::: "memory");
            const unsigned og = xb_add(&bar[XB_TOP], 1u);
            const unsigned tg = og / nx;
            if (og + 1u == (tg + 1u) * nx) xb_add(&bar[XB_TOPGEN], 1u);
            else XB_SPIN(xb_ld(&bar[XB_TOPGEN]) == tg, bar);
            __builtin_amdgcn_fence(__ATOMIC_ACQUIRE, "agent");
            xb_add(&bar[XB_XGEN(x)], 1u);
            asm volatile("s_waitcnt vmcnt(0)" ::: "memory");
        } else {
            XB_SPIN(xb_ld(&bar[XB_XGEN(x)]) == gen, bar);
            __builtin_amdgcn_fence(__ATOMIC_ACQUIRE, "agent");
            asm volatile("s_waitcnt vmcnt(0)" ::: "memory");
        }
    }
    __syncthreads();
}

struct Params { const void* in[28]; float* out; unsigned char* ws; };
__device__ __forceinline__ void* kload(int i) {
    const __attribute__((address_space(4))) char* ka = (const __attribute__((address_space(4))) char*)__builtin_amdgcn_kernarg_segment_ptr();
    asm volatile("" : "+s"(ka));
    return *(void* const __attribute__((address_space(4)))*)(ka + 8 * i);
}

__global__ void __launch_bounds__(NTHR, 2) mega_fwd(Params p) {
    extern __shared__ __attribute__((aligned(16))) unsigned char lds_raw[];
    LAS unsigned char* lds = (LAS unsigned char*)lds_raw;
    cg::grid_group grid = cg::this_grid();
    const int G = gridDim.x, bx = blockIdx.x, NGW = G * NWAVES;
    volatile LAS unsigned* const bar_st = (volatile LAS unsigned*)(lds + (LDS_BYTES - 64));
    if (threadIdx.x < 2) bar_st[threadIdx.x] = 0u;
    if (threadIdx.x == 0) (void)xb_add(&((unsigned*)(kload(29)) + OFF_BAR / 4)[XB_XCNT(xb_xcc_id())], 1u);
    __syncthreads();
#define GRID_BAR() xcd_barrier((unsigned*)(WSB + OFF_BAR), bar_st)
#define FRESH_IDS int tid_f = threadIdx.x; asm volatile("" : "+v"(tid_f)); const int tid = tid_f, lane = tid & 63, wave = __builtin_amdgcn_readfirstlane(tid >> 6), gw = bx * NWAVES + wave; LAS float* scr = (LAS float*)(lds + wave * 16896); (void)scr; (void)gw; (void)lane; (void)tid;
#define KARG(i) (kload(i))
#define WSB ((unsigned char*)kload(29))
#define x_in ((const float*)KARG(0))
#define mem ((const float*)KARG(1))
#define positions ((const int*)KARG(2))
#define ffn1_norm ((const float*)KARG(3))
#define ffn1_gu ((const float*)KARG(4))
#define ffn1_dn ((const float*)KARG(5))
#define mix_norm ((const float*)KARG(6))
#define mem_norm ((const float*)KARG(7))
#define w_mem_kv ((const float*)KARG(8))
#define mem_q_norm ((const float*)KARG(9))
#define mem_k_norm ((const float*)KARG(10))
#define w_out ((const float*)KARG(11))
#define ffn2_norm ((const float*)KARG(12))
#define ffn2_gu ((const float*)KARG(13))
#define ffn2_dn ((const float*)KARG(14))
#define lru_w_in ((const float*)KARG(15))
#define lru_conv_w ((const float*)KARG(16))
#define lru_conv_b ((const float*)KARG(17))
#define lru_gate_w ((const float*)KARG(18))
#define lru_gate_b ((const float*)KARG(19))
#define lru_lambda ((const float*)KARG(20))
#define mla_w_in ((const float*)KARG(21))
#define mla_q_a_norm ((const float*)KARG(22))
#define mla_w_uq ((const float*)KARG(23))
#define mla_kv_a_norm ((const float*)KARG(24))
#define mla_w_ukv ((const float*)KARG(25))
#define mla_q_norm ((const float*)KARG(26))
#define mla_k_norm ((const float*)KARG(27))
#define xout ((float*)KARG(28))
#define SSQ ((float*)(WSB + OFF_SSQ))
#define SSQC ((float*)(WSB + OFF_SSQC))
#define SSQM ((float*)(WSB + OFF_SSQM))
#define SPB ((float*)(WSB + OFF_SPB))
#define PBUF ((float*)(WSB + OFF_PBUF))
#define HEND ((float*)(WSB + OFF_HEND))
#define CARRY ((float*)(WSB + OFF_CARRY))
#define MKV ((float*)(WSB + OFF_MKV))
#define MEMK ((bf16*)(WSB + OFF_MEMK))
#define MEMVT ((bf16*)(WSB + OFF_MEMVT))
#define MEMB ((bf16*)(WSB + OFF_MEMB))
#define WGT ((bf16*)(WSB + OFF_WGT))
#define WMEM ((bf16*)(WSB + OFF_WMEM))
#define WOUT ((bf16*)(WSB + OFF_WOUT))
#define WIN ((bf16*)(WSB + OFF_WIN))
#define WUQ ((bf16*)(WSB + OFF_WUQ))
#define WKV ((bf16*)(WSB + OFF_WKV))
#define WGU1 ((bf16*)(WSB + OFF_WGU1))
#define WD1 ((bf16*)(WSB + OFF_WD1))
#define WGU2 ((bf16*)(WSB + OFF_WGU2))
#define WD2 ((bf16*)(WSB + OFF_WD2))
#define XB ((bf16*)(WSB + OFF_XB))
#define VT ((bf16*)(WSB + OFF_XB))
#define HB ((bf16*)(WSB + OFF_H))
#define UB ((bf16*)(WSB + OFF_H))
#define KN ((bf16*)(WSB + OFF_H + 64 * MiB))
#define MIX ((bf16*)(WSB + OFF_H + 112 * MiB))
#define QRAW ((bf16*)(WSB + OFF_QRAW))
#define KH ((bf16*)(WSB + OFF_KH))

    for (int rep_ = 0; rep_ < PROBE_SMALL_REPS; ++rep_) if (PH_MASK & 1) {
        FRESH_IDS
        int it = gw;
        TJOB(ffn1_gu, DM, NGU, ffn1_norm, WGU1, 1);
        TJOB(ffn1_dn, FF, DM, (const float*)nullptr, WD1, 0);
        for (int j = 0; j < 2; ++j) {
            TJOB(lru_w_in + (size_t)j * DM * LRU_IN, DM, LRU_IN, mix_norm + (2 * j) * DM, WIN + (size_t)j * LRU_IN * DM, 0);
            TJOB(mla_w_in + (size_t)j * DM * MLA_IN, DM, MLA_IN, mix_norm + (2 * j + 1) * DM, WIN + (size_t)2 * LRU_IN * DM + (size_t)j * MLA_INP * DM, 0);
            TJOB(mla_w_uq + (size_t)j * QL * NQ, QL, NQ, mla_q_a_norm + j * QL, WUQ + (size_t)j * NQP * QL, 0);
            TJOB(mla_w_ukv + (size_t)j * KVL * 1536, KVL, 1536, mla_kv_a_norm + j * KVL, WKV + (size_t)j * 1536 * KVL, 2);
        }
        for (int l = 0; l < NLAYERS_RUN; ++l) {
            TJOB(w_out + (size_t)l * DM * DM, DM, DM, (const float*)nullptr, WOUT + (size_t)l * DM * DM, 0);
            TJOB(w_mem_kv + (size_t)l * DM * 512, DM, 512, mem_norm + l * DM, WMEM + (size_t)l * 512 * DM, 0);
        }
        const int gt = bx * NTHR + tid, NGT = G * NTHR;
        for (int j = 0; j < 2; ++j) {
            u32x4* z1 = (u32x4*)(WIN + (size_t)2 * LRU_IN * DM + (size_t)j * MLA_INP * DM + (size_t)MLA_IN * DM);
            for (int i = gt; i < (MLA_INP - MLA_IN) * DM / 8; i += NGT) z1[i] = (u32x4){0, 0, 0, 0};
            u32x4* z2 = (u32x4*)(WUQ + (size_t)j * NQP * QL + (size_t)NQ * QL);
            for (int i = gt; i < (NQP - NQ) * QL / 8; i += NGT) z2[i] = (u32x4){0, 0, 0, 0};
        }
        { bf16* const wgt = WGT; const float* const gwp = lru_gate_w;
          for (int i = gt; i < 2 * 2 * 2 * 8 * 96 * 96; i += NGT) { const int k = i % 96, j = (i / 96) % 96, blk = i / 9216; wgt[i] = (bf16)(cvt_pk_bf16(gwp[(size_t)blk * 9216 + k * 96 + j], 0.f) & 0xffffu); } }
        { float* const sq = SSQ;
          { float* const spb = SPB; const float* const lmp = lru_lambda; for (int i = gt; i < 2 * 2 * LRUW; i += NGT) spb[i] = log1pf(__expf(-lmp[i])); }
          const float* const xi = x_in; bf16* const xb = XB;
          for (int m = gw; m < MTOK; m += NGW) row_to_bf16_ssq(xi + (size_t)m * DM, xb + (size_t)m * DM, sq + (size_t)m * 16, 16, lane);
          const float* const mi = mem; bf16* const mb = MEMB; float* const sqm = SSQM;
          for (int m = gw; m < BATCH * MEML; m += NGW) row_to_bf16_ssq(mi + (size_t)m * DM, mb + (size_t)m * DM, sqm + m, 1, lane); }
    }
    grid.sync(); if (PROBE_SYNC2) grid.sync();

    for (int l = 0; l < NLAYERS_RUN; ++l) {
        const int j2 = l >> 1; const bool is_lru = (l & 1) == 0;
        {
            pg8::Gemm g{XB, WGU1, DM, DM, MTOK, NGU, DM}; pg8::StaticOrder S; S.init(g.M, g.N, G, bx);
            pg8::EpiSwiglu E{HB, SSQ + (size_t)(3 * l) * MTOK * 16}; for (int rep_ = 0; rep_ < PROBE_GU_REPS; ++rep_) if ((PH_MASK & 2) && (GM_MASK & 2)) pg8::gemm_phase(lds, g, S, E);
        }
        GRID_BAR(); if (PROBE_SYNC2) GRID_BAR();
        {
            pg8::Gemm g{HB, WD1, FF, FF, MTOK, DM, FF}; pg8::StaticOrder S; S.init(g.M, g.N, G, bx);
            pg8::EpiRes E{l == 0 ? x_in : xout, xout, XB, SSQ + (size_t)(3 * l + 1) * MTOK * 16, 0.5f}; if ((PH_MASK & 2) && (GM_MASK & 4)) pg8::gemm_phase(lds, g, S, E);
        }
        GRID_BAR(); if (PROBE_SYNC2) GRID_BAR();
        {
            const int N = is_lru ? LRU_IN : MLA_INP;
            const bf16* Wt = is_lru ? WIN + (size_t)j2 * LRU_IN * DM : WIN + (size_t)2 * LRU_IN * DM + (size_t)j2 * MLA_INP * DM;
            pg8::Gemm g{XB, Wt, DM, DM, MTOK, N, DM}; pg8::StaticOrder S; S.init(g.M, g.N, G, bx);
            pg8::EpiU E{UB, N, SSQ + (size_t)(3 * l + 1) * MTOK * 16, SSQC + (size_t)(2 * j2) * MTOK * 8, SSQC + (size_t)(2 * j2 + 1) * MTOK * 8, is_lru ? 0 : 1};
            if ((PH_MASK & 2) && (GM_MASK & 8)) pg8::gemm_phase(lds, g, S, E);
            if (l == 0) {
                const int off = (G == 256) ? 128 : 0;
                if (bx >= off) { pg8::Gemm g2{MEMB, WMEM, DM, DM, BATCH * MEML, 2048, DM}; pg8::StaticOrder S2; S2.init(g2.M, g2.N, G - off, bx - off);
                    pg8::EpiMemKV E2{MKV, SSQM}; if ((PH_MASK & 2) && (GM_MASK & 1)) pg8::gemm_phase(lds, g2, S2, E2); }
            }
            for (int rep_ = 0; rep_ < PROBE_SMALL_REPS; ++rep_) {
            FRESH_IDS
            int it = gw;
            TJOB(ffn2_gu + (size_t)l * DM * NGU, DM, NGU, ffn2_norm + l * DM, WGU2, 1);
            TJOB(ffn2_dn + (size_t)l * FF * DM, FF, DM, (const float*)nullptr, WD2, 0);
            if (l < 3) {
                TJOB(ffn1_gu + (size_t)(l + 1) * DM * NGU, DM, NGU, ffn1_norm + (l + 1) * DM, WGU1, 1);
                TJOB(ffn1_dn + (size_t)(l + 1) * FF * DM, FF, DM, (const float*)nullptr, WD1, 0);
            }
            }
        }
        GRID_BAR(); if (PROBE_SYNC2) GRID_BAR();
        if (is_lru) {
            const float* cw = lru_conv_w + (size_t)j2 * 4 * LRUW; const float* cb = lru_conv_b + (size_t)j2 * LRUW;
            const bf16* wg = WGT + (size_t)j2 * 32 * 9216; const float* gb = lru_gate_b + (size_t)j2 * 4 * LRUW; const float* lm = SPB + (size_t)j2 * 2 * LRUW;
            for (int rep_ = 0; rep_ < PROBE_SMALL_REPS; ++rep_) if (l == 0) {
            FRESH_IDS
            const float* const mkv = MKV; const float* const mkn = mem_k_norm; bf16* const memk = MEMK; bf16* const memvt = MEMVT;
            for (int row = gw; row < 4 * 2 * 4 * 256; row += NGW) {
                const int m = row & 255, hh = (row >> 8) & 3, bb = (row >> 10) & 1, ll = row >> 11;
                const float* src = mkv + (size_t)(bb * 256 + m) * 2048 + ll * 512 + hh * 64 + lane;
                const float kraw = src[0], vraw = src[256];
                const float ss = wave_sum(kraw * kraw);
                const float kn = kraw * rsqrtf(ss * (1.f / 64) + EPS) * mkn[ll * 64 + lane];
                const size_t base = (size_t)((ll * 2 + bb) * 4 + hh);
                memk[(base * 256 + m) * 64 + lane] = (bf16)(cvt_pk_bf16(kn, 0.f) & 0xffffu);
                memvt[((base * 4 + (m >> 6)) * 64 + lane) * 64 + (m & 63)] = (bf16)(cvt_pk_bf16(vraw, 0.f) & 0xffffu);
            }
        }
            for (int rep_ = 0; rep_ < PROBE_LRU_REPS; ++rep_) if (PH_MASK & 4) { int cur_n = -1; for (int item = bx; item < 4096; item += G) { if ((item & 7) != cur_n) { cur_n = item & 7; __syncthreads(); lru_load_consts(lds, cur_n, cw, cb, gb, lm); __syncthreads(); } lru_item<false>(lds, item, UB, cw, cb, wg, gb, lm, PBUF, HEND, CARRY, MIX); } }
            GRID_BAR(); if (PROBE_SYNC2) GRID_BAR();
            for (int rep_ = 0; rep_ < PROBE_SMALL_REPS; ++rep_) { FRESH_IDS if (wave == 0 && bx < 48) {
                const int gid = bx * 64 + lane, ch = gid % LRUW, bd = gid / LRUW, dir = bd & 1;
                const float* const pbuf = PBUF; const float* const hend = HEND; float* const carry = CARRY;
                float hst = 0.f;
                for (int s8 = 0; s8 < 32; ++s8) {
                    float pv[8], hv[8];
#pragma unroll
                    for (int j = 0; j < 8; ++j) { const int st = s8 * 8 + j, c = dir ? 255 - st : st; const size_t idx = ((size_t)(bd * 256 + c)) * LRUW + ch; pv[j] = pbuf[idx]; hv[j] = hend[idx]; }
#pragma unroll
                    for (int j = 0; j < 8; ++j) { const int st = s8 * 8 + j, c = dir ? 255 - st : st; carry[((size_t)(bd * 256 + c)) * LRUW + ch] = hst; hst = pv[j] * hst + hv[j]; }
                }
            } }
            GRID_BAR(); if (PROBE_SYNC2) GRID_BAR();
            for (int rep_ = 0; rep_ < PROBE_LRU_REPS; ++rep_) if (PH_MASK & 8) { int cur_n = -1; for (int item = bx; item < 4096; item += G) { if ((item & 7) != cur_n) { cur_n = item & 7; __syncthreads(); lru_load_consts(lds, cur_n, cw, cb, gb, lm); __syncthreads(); } lru_item<true>(lds, item, UB, cw, cb, wg, gb, lm, PBUF, HEND, CARRY, MIX); } }
        } else {
            float* ssq_cq = SSQC + (size_t)(2 * j2) * MTOK * 8; float* ssq_ckv = SSQC + (size_t)(2 * j2 + 1) * MTOK * 8;
            {
                pg8::Gemm g{UB, WUQ + (size_t)j2 * NQP * QL, MLA_INP, QL, MTOK, NQP, QL}; pg8::StaticOrder S; S.init(g.M, g.N, G, bx);
                pg8::EpiRowScale E{QRAW, NQ, NQ, ssq_cq, 1.f / QL}; if ((PH_MASK & 2) && (GM_MASK & 16)) pg8::gemm_phase(lds, g, S, E);
            }
            {
                pg8::Gemm g{UB + QL, WKV + (size_t)j2 * 1536 * KVL, MLA_INP, KVL, MTOK, 768, KVL}; pg8::StaticOrder S; S.init(g.M, g.N, G, bx);
                pg8::EpiRowScale E{KN, 768, 768, ssq_ckv, 1.f / KVL}; if ((PH_MASK & 2) && (GM_MASK & 32)) pg8::gemm_phase(lds, g, S, E);
            }
            {
                pg8::Gemm g{WKV + (size_t)j2 * 1536 * KVL + (size_t)768 * KVL, UB + QL, KVL, MLA_INP, 768, MTOK, KVL}; pg8::StaticOrder S; S.init(g.M, g.N, G, bx);
                pg8::EpiVt E{VT, ssq_ckv}; if ((PH_MASK & 2) && (GM_MASK & 64)) pg8::gemm_phase(lds, g, S, E);
            }
            GRID_BAR(); if (PROBE_SYNC2) GRID_BAR();
            for (int rep_ = 0; rep_ < PROBE_SMALL_REPS; ++rep_) if (PH_MASK & 16) {
                FRESH_IDS
                const float* kg = mla_k_norm + j2 * DQK;
                const int hg = lane >> 4, l16 = lane & 15;
                const f32x4 kgn = *(const f32x4*)(kg + l16 * 4); const float kg1 = kg[64 + l16], kg2 = kg[80 + l16];
                const float invf = rope_inv_freq(l16);
                const bf16* const ub = UB; const bf16* const kn_ = KN; bf16* const kh = KH; const int* const posp = positions;
#pragma unroll 4
                for (int tok = gw; tok < MTOK; tok += NGW) {
                    const int b = tok >> 14, s = tok & (SEQ - 1);
                    const float x1 = bf2f(ub[(size_t)tok * MLA_INP + 640 + l16]), x2 = bf2f(ub[(size_t)tok * MLA_INP + 656 + l16]);
                    float sn, cs; sincos_big((float)posp[tok] * invf, sn, cs);
#pragma unroll
                    for (int pss = 0; pss < 3; ++pss) { const int head = pss * 4 + hg;
                        const u32x2 raw = *(const u32x2*)(kn_ + (size_t)tok * 768 + head * 64 + l16 * 4);
                        const float n0 = bflo(raw.x), n1 = bfhi(raw.x), n2 = bflo(raw.y), n3 = bfhi(raw.y);
                        float ss = (n0 * n0 + n1 * n1) + (n2 * n2 + n3 * n3) + (x1 * x1 + x2 * x2);
                        ss += __shfl_xor(ss, 1); ss += __shfl_xor(ss, 2); ss += __shfl_xor(ss, 4); ss += __shfl_xor(ss, 8);
                        const float rs = rsqrtf(ss * (1.f / DQK) + EPS);
                        bf16* dst = kh + ((size_t)(b * NH + head) * SEQ + s) * DQK;
                        u32x2 w; w.x = cvt_pk_bf16(n0 * rs * kgn[0], n1 * rs * kgn[1]); w.y = cvt_pk_bf16(n2 * rs * kgn[2], n3 * rs * kgn[3]);
                        *(u32x2*)(dst + l16 * 4) = w;
                        const float y1 = x1 * rs * kg1, y2 = x2 * rs * kg2;
                        const unsigned pr = cvt_pk_bf16(y1 * cs - y2 * sn, y2 * cs + y1 * sn);
                        dst[64 + l16] = (bf16)(pr & 0xffffu); dst[80 + l16] = (bf16)(pr >> 16);
                    }
                }
            }
            GRID_BAR(); if (PROBE_SYNC2) GRID_BAR();
            for (int rep_ = 0; rep_ < PROBE_ATTN_REPS; ++rep_) if (PH_MASK & 32) {
                const float qs = 0.10206207261596577f * 1.4426950408889634f;
                const float* qg = mla_q_norm + j2 * DQK; const float* kgp = mla_k_norm + j2 * DQK;
                if ((G & 7) == 0) {
                    const int xcd = bx & 7, jj = bx >> 3, nper = G >> 3;
                    for (int li = jj; li < 192; li += nper) { const int bh = xcd + 8 * (li >> 6), qb = li & 63, b = bh / NH, hh = bh % NH;
                        attn_unit<96, true>(lds, QRAW + hh * DQK, NQ, b * SEQ + qb * 256, qg, kgp, positions, KH + (size_t)bh * SEQ * DQK, VT + (size_t)bh * DV * SEQ, SEQ, MIX + hh * DV, DM, qs); }
                } else {
                    for (int un = bx; un < 1536; un += G) { const int bh = un >> 6, qb = un & 63, b = bh / NH, hh = bh % NH;
                        attn_unit<96, true>(lds, QRAW + hh * DQK, NQ, b * SEQ + qb * 256, qg, kgp, positions, KH + (size_t)bh * SEQ * DQK, VT + (size_t)bh * DV * SEQ, SEQ, MIX + hh * DV, DM, qs); }
                }
            }
        }
        for (int rep_ = 0; rep_ < PROBE_SMALL_REPS; ++rep_) if (PH_MASK & 64) {
            const int ldu = is_lru ? LRU_IN : MLA_INP, moff = is_lru ? 1536 : 672;
            const float qs = 0.125f * 1.4426950408889634f;
            for (int un = bx; un < 512; un += G) { const int qb = un & 63, hh = (un >> 6) & 3, b = un >> 8;
                const size_t base = (size_t)((l * 2 + b) * 4 + hh);
                attn_unit<64, false>(lds, UB + moff + hh * 64, ldu, b * SEQ + qb * 256, mem_q_norm + l * 64, mem_k_norm + l * 64, positions, MEMK + base * 256 * 64, MEMVT + base * 64 * 256, MEML, MIX + 768 + hh * 64, DM, qs); }
        }
        GRID_BAR(); if (PROBE_SYNC2) GRID_BAR();
        {
            pg8::Gemm g{MIX, WOUT + (size_t)l * DM * DM, DM, DM, MTOK, DM, DM}; pg8::StaticOrder S; S.init(g.M, g.N, G, bx);
            pg8::EpiRes E{xout, xout, XB, SSQ + (size_t)(3 * l + 2) * MTOK * 16, 1.0f}; if ((PH_MASK & 2) && (GM_MASK & 128)) pg8::gemm_phase(lds, g, S, E);
        }
        GRID_BAR(); if (PROBE_SYNC2) GRID_BAR();
        {
            pg8::Gemm g{XB, WGU2, DM, DM, MTOK, NGU, DM}; pg8::StaticOrder S; S.init(g.M, g.N, G, bx);
            pg8::EpiSwiglu E{HB, SSQ + (size_t)(3 * l + 2) * MTOK * 16}; for (int rep_ = 0; rep_ < PROBE_GU_REPS; ++rep_) if ((PH_MASK & 2) && (GM_MASK & 256)) pg8::gemm_phase(lds, g, S, E);
        }
        GRID_BAR(); if (PROBE_SYNC2) GRID_BAR();
        {
            pg8::Gemm g{HB, WD2, FF, FF, MTOK, DM, FF}; pg8::StaticOrder S; S.init(g.M, g.N, G, bx);
            pg8::EpiRes E{xout, xout, l == 3 ? (bf16*)nullptr : XB, SSQ + (size_t)(3 * l + 3) * MTOK * 16, 0.5f}; if ((PH_MASK & 2) && (GM_MASK & 512)) pg8::gemm_phase(lds, g, S, E);
        }
        if (l < 3) { GRID_BAR(); if (PROBE_SYNC2) GRID_BAR(); }
    }
}

extern "C" void kernel_launch(void* const* d_in, const int* in_sizes, int n_in, void* d_out, int out_size, void* d_ws, size_t ws_size, hipStream_t stream) {
    static int grid = 0;
    if (grid == 0) {
        if (n_in != 28 || ws_size < WS_END) { fprintf(stderr, "kernel_launch: unexpected n_in %d / ws_size %zu (need %zu)\n", n_in, ws_size, (size_t)WS_END); grid = -1; return; }
        int dev = 0, cus = 0, per_cu = 0;
        hipGetDevice(&dev); hipDeviceGetAttribute(&cus, hipDeviceAttributeMultiprocessorCount, dev);
        if (hipFuncSetAttribute((const void*)mega_fwd, hipFuncAttributeMaxDynamicSharedMemorySize, LDS_BYTES) != hipSuccess) { fprintf(stderr, "kernel_launch: hipFuncSetAttribute failed\n"); }
        if (hipOccupancyMaxActiveBlocksPerMultiprocessor(&per_cu, (const void*)mega_fwd, NTHR, LDS_BYTES) != hipSuccess || per_cu < 1) { fprintf(stderr, "kernel_launch: occupancy query gave %d\n", per_cu); per_cu = 1; }
        (void)hipGetLastError();
        grid = cus * per_cu;
    }
    if (grid < 0) return;
    if (hipMemsetAsync((char*)d_ws + OFF_BAR, 0, 16384, stream) != hipSuccess) { fprintf(stderr, "kernel_launch: memset of barrier words failed\n"); return; }
    Params p{};
    for (int i = 0; i < 28; ++i) p.in[i] = d_in[i];
    p.out = (float*)d_out; p.ws = (unsigned char*)d_ws;
    void* args[] = {&p};
    hipError_t e = hipLaunchCooperativeKernel((const void*)mega_fwd, dim3(grid), dim3(NTHR), args, LDS_BYTES, stream);
    if (e != hipSuccess) fprintf(stderr, "cooperative launch failed: %s (grid %d)\n", hipGetErrorString(e), grid);
}
```

```cpp
#include <hip/hip_runtime.h>
#include <hip/hip_cooperative_groups.h>
#include <cstdio>
#include <cstdint>
namespace cg = cooperative_groups;

#define LAS __attribute__((address_space(3)))
typedef unsigned short bf16;
typedef short bf16x8 __attribute__((ext_vector_type(8)));
typedef float f32x4 __attribute__((ext_vector_type(4)));
typedef float f32x16 __attribute__((ext_vector_type(16)));
typedef unsigned u32x4 __attribute__((ext_vector_type(4)));
typedef unsigned u32x2 __attribute__((ext_vector_type(2)));

constexpr int BATCH = 2, SEQ = 16384, MTOK = BATCH * SEQ, DM = 1024, FF = 2816, NGU = 2 * FF;
constexpr int LRUW = 768, LRU_IN = 1792, MLA_INP = 1024  , MLA_IN = 928;
constexpr int QL = 384, KVL = 256, NH = 12, DQK = 96, DV = 64, NQ = NH * DQK  , NQP = 1280;
constexpr int MEML = 256, MEMH = 4;
constexpr float EPS = 1e-6f;
constexpr int NTHR = 512, NWAVES = 8;
constexpr int LDS_BYTES = 147456;
#ifndef PROBE_ATTN_REPS
#define PROBE_ATTN_REPS 1
#endif
#ifndef PROBE_LRU_REPS
#define PROBE_LRU_REPS 1
#endif
#ifndef PROBE_GU_REPS
#define PROBE_GU_REPS 1
#endif
#ifndef PROBE_SMALL_REPS
#define PROBE_SMALL_REPS 1
#endif
#ifndef PROBE_SYNC2
#define PROBE_SYNC2 0
#endif
#ifndef NLAYERS_RUN
#define NLAYERS_RUN 4
#endif
#ifndef GM_MASK
#define GM_MASK 0xFFFF
#endif
#ifndef PH_MASK
#define PH_MASK 0xFFFF
#endif

constexpr size_t MiB = 1u << 20;
constexpr size_t OFF_SSQ = 466 * MiB;
constexpr size_t OFF_SSQC = 492 * MiB;
constexpr size_t OFF_SSQM = 2 * MiB + 768 * 1024;
constexpr size_t OFF_SPB = OFF_SSQM + 8192;
constexpr size_t OFF_PBUF = 3 * MiB, OFF_HEND = 6 * MiB, OFF_CARRY = 9 * MiB;
constexpr size_t OFF_MKV = 12 * MiB;
constexpr size_t OFF_MEMK = 16 * MiB, OFF_MEMVT = 17 * MiB, OFF_MEMB = 18 * MiB;
constexpr size_t OFF_WGT = 19 * MiB;
constexpr size_t OFF_WMEM = 21 * MiB;
constexpr size_t OFF_WOUT = 25 * MiB;
constexpr size_t OFF_WIN = 33 * MiB;
constexpr size_t OFF_WUQ = 44 * MiB;
constexpr size_t OFF_WKV = 46 * MiB;
constexpr size_t OFF_WGU1 = 48 * MiB, OFF_WD1 = 59 * MiB, OFF_WGU2 = 65 * MiB, OFF_WD2 = 76 * MiB;
constexpr size_t OFF_XB = 82 * MiB;
constexpr size_t OFF_H = 146 * MiB;
constexpr size_t OFF_QRAW = 322 * MiB;
constexpr size_t OFF_KH = 394 * MiB;
constexpr size_t OFF_BAR = 496 * MiB;
constexpr size_t WS_END = 497 * MiB;

typedef __bf16 bf16x2_t __attribute__((ext_vector_type(2)));
typedef float f32x2_t __attribute__((ext_vector_type(2)));
__device__ __forceinline__ unsigned cvt_pk_bf16(float lo, float hi) { f32x2_t v = {lo, hi}; bf16x2_t b = __builtin_convertvector(v, bf16x2_t); return __builtin_bit_cast(unsigned, b); }
__device__ __forceinline__ float bf2f(unsigned short b) { return __builtin_bit_cast(float, (unsigned)b << 16); }
__device__ __forceinline__ float bflo(unsigned w) { return __builtin_bit_cast(float, w << 16); }
__device__ __forceinline__ float bfhi(unsigned w) { return __builtin_bit_cast(float, w & 0xffff0000u); }
__device__ __forceinline__ float wave_sum(float v) {
#pragma unroll
    for (int o = 1; o < 64; o <<= 1) v += __shfl_xor(v, o);
    return v;
}
__device__ __forceinline__ float sum16(const float* p) { const f32x4 a = *(const f32x4*)p, b = *(const f32x4*)(p + 4), c = *(const f32x4*)(p + 8), d = *(const f32x4*)(p + 12);
    return (((a[0] + a[1]) + (a[2] + a[3])) + ((b[0] + b[1]) + (b[2] + b[3]))) + (((c[0] + c[1]) + (c[2] + c[3])) + ((d[0] + d[1]) + (d[2] + d[3]))); }
__device__ __forceinline__ float quarter_sum(const f32x4 q) { float v = (q[0] + q[1]) + (q[2] + q[3]); v += __shfl_xor(v, 16); v += __shfl_xor(v, 32); return v; }
__device__ __forceinline__ float sum8(const float* p) { const f32x4 a = *(const f32x4*)p, b = *(const f32x4*)(p + 4); return ((a[0] + a[1]) + (a[2] + a[3])) + ((b[0] + b[1]) + (b[2] + b[3])); }
__device__ __forceinline__ float sigmoidf_(float x) { return __builtin_amdgcn_rcpf(1.f + __expf(-x)); }
__device__ __forceinline__ void sincos_big(float ang, float& s, float& c) {
    double rev = (double)ang * 0.15915494309189535; rev -= rint(rev); const float f = (float)rev;
    s = __builtin_amdgcn_sinf(f); c = __builtin_amdgcn_cosf(f);
}
__device__ __forceinline__ float rope_inv_freq(int i) { return exp2f(-(float)i * (13.287712379549449f / 16.f)); }

namespace pg8 {
constexpr int BM = 256, BK = 64, HALF = 128, HTB = HALF * BK * 2, STAGE_BYTES = 8 * HTB, NXCD = 8, WGM = 8;
__host__ __device__ __forceinline__ int lds_byte(int r, int c) { const int st = (r >> 4) * 2 + (c >> 5), rr = r & 15, cc = c & 31, ob = rr * 64 + cc * 2; return st * 1024 + (ob ^ (((ob >> 9) & 1) << 5)); }
__host__ __device__ __forceinline__ void stage_rc(int b, int& R, int& C) { const int st = b / 1024, sb = b % 1024, swz = sb ^ (((sb >> 9) & 1) << 5); R = (st >> 1) * 16 + swz / 64; C = (st & 1) * 32 + (swz % 64) / 2; }
__host__ __device__ __forceinline__ int perm32(int rho) { const int n = rho >> 4, i = rho & 15; return 8 * (i >> 2) + 4 * n + (i & 3); }
struct Unit { int pm, pn; };
struct Gemm { const bf16* A; const bf16* Bt; int lda, ldb, M, N, K; };
struct StaticOrder {
    int nM, nN, nwg, G, c;
    __device__ void init(int M, int N, int G_, int c_) { asm volatile("" : "+s"(c_)); nM = M / BM; nN = N / BM; nwg = nM * nN; G = G_; c = c_; }
    __device__ bool next(int i, Unit& u) const {
        const long L = (long)i * G + c; if (L >= nwg) return false;
        int wgid = (int)L; { const int q = nwg / NXCD, r = nwg % NXCD, xcd = wgid % NXCD, off = wgid / NXCD; wgid = (xcd < r ? xcd * (q + 1) : r * (q + 1) + (xcd - r) * q) + off; }
        const int nig = WGM * nN, gid = wgid / nig, fm = gid * WGM, gsz = (nM - fm) < WGM ? (nM - fm) : WGM;
        u.pm = fm + ((wgid % nig) % gsz); u.pn = (wgid % nig) / gsz; return true;
    }
};
template <class Epi>
__device__ __forceinline__ void gemm_phase(LAS unsigned char* lds, const Gemm g, const StaticOrder& S, const Epi& E) {
    int tid_ = threadIdx.x; asm volatile("" : "+v"(tid_));
    const int tid = tid_, wid = __builtin_amdgcn_readfirstlane(tid >> 6), lane = tid & 63, wr = wid >> 2, wc = wid & 3, fr = lane & 15, fq = lane >> 4;
    const int K = g.K, nt = K / BK;
    unsigned voffA[2], voffB[2];
#pragma unroll
    for (int i = 0; i < 2; ++i) { int R, C; stage_rc(tid * 16 + i * 8192, R, C); const int Rb = (R & ~31) + perm32(R & 31);
        voffA[i] = (unsigned)(R * g.lda + C) * 2u; voffB[i] = (unsigned)(Rb * g.ldb + C) * 2u; }
    const size_t kstep = (size_t)(BK * 2);
    const size_t hsA = (size_t)HALF * g.lda * 2, hsB = (size_t)HALF * g.ldb * 2;
    const size_t tsA = 2 * hsA, tsB = 2 * hsB;
    const unsigned ldsw = (unsigned)wid * 1024u;
    const int aoff = lds_byte(wr * 64 + fr, fq * 8), boff = lds_byte(wc * 32 + fr, fq * 8);
#define PG8_SA(b, h) (((b) * 2 + (h)) * HTB)
#define PG8_SB(b, h) ((4 + (b) * 2 + (h)) * HTB)
#define PG8_STAGE(bufoff, gbase, voff) do { _Pragma("unroll") for (int _i = 0; _i < 2; ++_i) \
        __builtin_amdgcn_global_load_lds((const unsigned*)((const char*)(gbase) + (voff)[_i]), (LAS unsigned*)(lds + (bufoff) + ldsw + _i * 8192), 16, 0, 0); } while (0)
#define PG8_LDA(dst, b, h) do { _Pragma("unroll") for (int m = 0; m < 4; ++m) _Pragma("unroll") for (int k = 0; k < 2; ++k) dst[m][k] = *(const LAS bf16x8*)(lds + PG8_SA(b, h) + aoff + m * 2048 + k * 1024); } while (0)
#define PG8_LDB(dst, b, h) do { _Pragma("unroll") for (int n = 0; n < 2; ++n) _Pragma("unroll") for (int k = 0; k < 2; ++k) dst[n][k] = *(const LAS bf16x8*)(lds + PG8_SB(b, h) + boff + n * 2048 + k * 1024); } while (0)
#define PG8_MMA(ai, bj, At, Bt) do { __builtin_amdgcn_s_setprio(1); _Pragma("unroll") for (int m = 0; m < 4; ++m) _Pragma("unroll") for (int n = 0; n < 2; ++n) _Pragma("unroll") for (int k = 0; k < 2; ++k) \
        acc[ai][bj][m][n] = __builtin_amdgcn_mfma_f32_16x16x32_bf16(Bt[n][k], At[m][k], acc[ai][bj][m][n], 0, 0, 0); __builtin_amdgcn_s_setprio(0); } while (0)
#define PG8_WAIT_V(n) asm volatile("s_waitcnt vmcnt(" #n ")" ::: "memory")
#define PG8_WAIT_L(n) asm volatile("s_waitcnt lgkmcnt(" #n ")" ::: "memory")
#define PG8_BAR __builtin_amdgcn_s_barrier()
#define PG8_SCHED __builtin_amdgcn_sched_barrier(0)
    Unit cur, nxt; int ui = 0;
    if (!S.next(0, cur)) return;
    f32x4 acc[2][2][4][2];
#pragma unroll
    for (int a = 0; a < 2; ++a)
#pragma unroll
        for (int b = 0; b < 2; ++b)
#pragma unroll
            for (int m = 0; m < 4; ++m)
#pragma unroll
                for (int n = 0; n < 2; ++n) acc[a][b][m][n] = (f32x4){0.f, 0.f, 0.f, 0.f};
    bf16x8 At[4][2], B0[2][2], B1[2][2];
    const char* cA = (const char*)g.A + (size_t)cur.pm * tsA; const char* cB = (const char*)g.Bt + (size_t)cur.pn * tsB;
    PG8_STAGE(PG8_SB(0, 0), cB, voffB); PG8_STAGE(PG8_SB(0, 1), cB + hsB, voffB); PG8_STAGE(PG8_SA(0, 0), cA, voffA); PG8_STAGE(PG8_SA(0, 1), cA + hsA, voffA);
    if (wr == 1) PG8_BAR;
    PG8_WAIT_V(2); PG8_BAR;
    PG8_STAGE(PG8_SB(1, 0), cB + kstep, voffB); PG8_STAGE(PG8_SA(1, 0), cA + kstep, voffA); PG8_STAGE(PG8_SB(1, 1), cB + hsB + kstep, voffB);
    PG8_WAIT_V(6); PG8_BAR;
    for (;;) {
        const bool has_next = S.next(ui + 1, nxt);
        const char* nA = has_next ? (const char*)g.A + (size_t)nxt.pm * tsA : cA; const char* nB = has_next ? (const char*)g.Bt + (size_t)nxt.pn * tsB : cB;
#pragma unroll 1
        for (int t = 0; t < nt; t += 2) {
            const bool last = (t == nt - 2);
            const char* a1 = cA + (size_t)(t + 1) * kstep;
            const char* a2 = last ? nA : cA + (size_t)(t + 2) * kstep; const char* b2 = last ? nB : cB + (size_t)(t + 2) * kstep;
            const char* a3 = a2 + kstep; const char* b3 = b2 + kstep;
            PG8_LDB(B0, 0, 0); PG8_LDB(B1, 0, 1); PG8_SCHED; PG8_LDA(At, 0, 0); PG8_STAGE(PG8_SA(1, 1), a1 + hsA, voffA);
            PG8_WAIT_V(8); PG8_WAIT_L(0); PG8_BAR; PG8_MMA(0, 0, At, B0); PG8_MMA(0, 1, At, B1); PG8_BAR; PG8_SCHED;
            PG8_LDA(At, 0, 1); PG8_STAGE(PG8_SB(0, 0), b2, voffB); PG8_STAGE(PG8_SB(0, 1), b2 + hsB, voffB); PG8_STAGE(PG8_SA(0, 0), a2, voffA);
            PG8_WAIT_V(8); PG8_WAIT_L(0); PG8_BAR; PG8_MMA(1, 0, At, B0); PG8_MMA(1, 1, At, B1); PG8_BAR; PG8_SCHED;
            PG8_LDB(B0, 1, 0); PG8_LDB(B1, 1, 1); PG8_SCHED; PG8_LDA(At, 1, 0); PG8_STAGE(PG8_SA(0, 1), a2 + hsA, voffA);
            PG8_WAIT_V(8); PG8_WAIT_L(0); PG8_BAR; PG8_MMA(0, 0, At, B0); PG8_MMA(0, 1, At, B1); PG8_BAR; PG8_SCHED;
            PG8_LDA(At, 1, 1); PG8_STAGE(PG8_SB(1, 0), b3, voffB); PG8_STAGE(PG8_SB(1, 1), b3 + hsB, voffB); PG8_STAGE(PG8_SA(1, 0), a3, voffA);
            PG8_WAIT_V(8); PG8_WAIT_L(0); PG8_BAR; PG8_MMA(1, 0, At, B0); PG8_MMA(1, 1, At, B1); PG8_BAR; PG8_SCHED;
        }
        if (wr == 0) PG8_BAR;
        E(acc, cur, wr, wc, fr, fq);
        if (!has_next) break;
        PG8_WAIT_V(0);
#pragma unroll
        for (int a = 0; a < 2; ++a)
#pragma unroll
            for (int b = 0; b < 2; ++b)
#pragma unroll
                for (int m = 0; m < 4; ++m)
#pragma unroll
                    for (int n = 0; n < 2; ++n) acc[a][b][m][n] = (f32x4){0.f, 0.f, 0.f, 0.f};
        cur = nxt; cA = nA; cB = nB; ++ui;
        if (wr == 1) PG8_BAR;
    }
    PG8_WAIT_V(0);
    PG8_BAR;
#undef PG8_SA
#undef PG8_SB
#undef PG8_STAGE
#undef PG8_LDA
#undef PG8_LDB
#undef PG8_MMA
#undef PG8_WAIT_V
#undef PG8_WAIT_L
#undef PG8_BAR
#undef PG8_SCHED
}

typedef const f32x4 (&AccRef)[2][2][4][2];
struct EpiSwiglu {
    bf16* H; const float* ssq;
    __device__ __forceinline__ void operator()(AccRef acc, const Unit& u, int wr, int wc, int fr, int fq) const {
        const int row0 = u.pm * BM + wr * 64 + fr, col0 = u.pn * HALF + wc * 32 + 8 * fq;
        f32x4 qv[2][4];
#pragma unroll
        for (int ai = 0; ai < 2; ++ai)
#pragma unroll
            for (int m = 0; m < 4; ++m) qv[ai][m] = *(const f32x4*)(ssq + (size_t)(row0 + ai * HALF + m * 16) * 16 + fq * 4);
#pragma unroll
        for (int ai = 0; ai < 2; ++ai)
#pragma unroll
            for (int m = 0; m < 4; ++m) { const int r = row0 + ai * HALF + m * 16; const float rs = rsqrtf(quarter_sum(qv[ai][m]) * (1.f / DM) + EPS);
                float o[8];
#pragma unroll
                for (int n = 0; n < 2; ++n) { const f32x4 gv = acc[ai][0][m][n] * rs, uv = acc[ai][1][m][n] * rs;
#pragma unroll
                    for (int i = 0; i < 4; ++i) o[n * 4 + i] = gv[i] * sigmoidf_(gv[i]) * uv[i]; }
                u32x4 w; w.x = cvt_pk_bf16(o[0], o[1]); w.y = cvt_pk_bf16(o[2], o[3]); w.z = cvt_pk_bf16(o[4], o[5]); w.w = cvt_pk_bf16(o[6], o[7]);
                *(u32x4*)(H + (size_t)r * FF + col0) = w; }
    }
};
struct EpiRes {
    const float* xin; float* xout; bf16* xb; float* ssq_out; float scale;
    __device__ __forceinline__ void operator()(AccRef acc, const Unit& u, int wr, int wc, int fr, int fq) const {
        const int row0 = u.pm * BM + wr * 64 + fr, col0 = u.pn * BM + wc * 32 + 8 * fq;
#pragma unroll
        for (int ai = 0; ai < 2; ++ai) {
            f32x4 xv[4][2][2];
#pragma unroll
            for (int m = 0; m < 4; ++m)
#pragma unroll
                for (int bj = 0; bj < 2; ++bj) { const size_t o = (size_t)(row0 + ai * HALF + m * 16) * DM + col0 + bj * HALF;
                    xv[m][bj][0] = *(const f32x4*)(xin + o); xv[m][bj][1] = *(const f32x4*)(xin + o + 4); }
            __builtin_amdgcn_sched_barrier(0);
#pragma unroll
            for (int m = 0; m < 4; ++m) { const int r = row0 + ai * HALF + m * 16; float part = 0.f;
#pragma unroll
                for (int bj = 0; bj < 2; ++bj) { const size_t o = (size_t)r * DM + col0 + bj * HALF;
                    const f32x4 x0 = xv[m][bj][0] + acc[ai][bj][m][0] * scale, x1 = xv[m][bj][1] + acc[ai][bj][m][1] * scale;
                    *(f32x4*)(xout + o) = x0; *(f32x4*)(xout + o + 4) = x1;
                    if (xb) { u32x4 w; w.x = cvt_pk_bf16(x0[0], x0[1]); w.y = cvt_pk_bf16(x0[2], x0[3]); w.z = cvt_pk_bf16(x1[0], x1[1]); w.w = cvt_pk_bf16(x1[2], x1[3]);
                        *(u32x4*)(xb + o) = w; }
                    part += (x0[0] * x0[0] + x0[1] * x0[1]) + (x0[2] * x0[2] + x0[3] * x0[3]) + (x1[0] * x1[0] + x1[1] * x1[1]) + (x1[2] * x1[2] + x1[3] * x1[3]); }
                part += __shfl_xor(part, 16); part += __shfl_xor(part, 32);
                if (fq == 0 && xb) ssq_out[(size_t)r * 16 + u.pn * 4 + wc] = part; }
        }
    }
};
struct EpiU {
    bf16* U; int ldu; const float* ssqx; float* ssq_cq; float* ssq_ckv; int mla;
    __device__ __forceinline__ void operator()(AccRef acc, const Unit& u, int wr, int wc, int fr, int fq) const {
        const int row0 = u.pm * BM + wr * 64 + fr, col0 = u.pn * BM + wc * 32 + 8 * fq;
        f32x4 qv[2][4];
#pragma unroll
        for (int ai = 0; ai < 2; ++ai)
#pragma unroll
            for (int m = 0; m < 4; ++m) qv[ai][m] = *(const f32x4*)(ssqx + (size_t)(row0 + ai * HALF + m * 16) * 16 + fq * 4);
#pragma unroll
        for (int ai = 0; ai < 2; ++ai)
#pragma unroll
            for (int m = 0; m < 4; ++m) { const int r = row0 + ai * HALF + m * 16; const float rs = rsqrtf(quarter_sum(qv[ai][m]) * (1.f / DM) + EPS); float pq = 0.f, pk = 0.f;
#pragma unroll
                for (int bj = 0; bj < 2; ++bj) { const f32x4 v0 = acc[ai][bj][m][0] * rs, v1 = acc[ai][bj][m][1] * rs;
                    u32x4 w; w.x = cvt_pk_bf16(v0[0], v0[1]); w.y = cvt_pk_bf16(v0[2], v0[3]); w.z = cvt_pk_bf16(v1[0], v1[1]); w.w = cvt_pk_bf16(v1[2], v1[3]);
                    *(u32x4*)(U + (size_t)r * ldu + col0 + bj * HALF) = w;
                    if (mla) { const float s = (v0[0] * v0[0] + v0[1] * v0[1]) + (v0[2] * v0[2] + v0[3] * v0[3]) + (v1[0] * v1[0] + v1[1] * v1[1]) + (v1[2] * v1[2] + v1[3] * v1[3]);
                        const int cc = u.pn * 2 + bj; if (cc < 3) pq += s; else if (cc < 5) pk += s; } }
                if (mla && u.pn < 3) { pq += __shfl_xor(pq, 16); pq += __shfl_xor(pq, 32); pk += __shfl_xor(pk, 16); pk += __shfl_xor(pk, 32);
                    if (fq == 0) { if (u.pn < 2) ssq_cq[(size_t)r * 8 + u.pn * 4 + wc] = pq; if (u.pn > 0) ssq_ckv[(size_t)r * 8 + (u.pn - 1) * 4 + wc] = pk; } } }
    }
};
struct EpiRowScale {
    bf16* O; int ldo, ncols; const float* ssq; float inv_dim;
    __device__ __forceinline__ void operator()(AccRef acc, const Unit& u, int wr, int wc, int fr, int fq) const {
        const int row0 = u.pm * BM + wr * 64 + fr, col0 = u.pn * BM + wc * 32 + 8 * fq;
#pragma unroll
        for (int ai = 0; ai < 2; ++ai)
#pragma unroll
            for (int m = 0; m < 4; ++m) { const int r = row0 + ai * HALF + m * 16; const float rs = rsqrtf(sum8(ssq + (size_t)r * 8) * inv_dim + EPS);
#pragma unroll
                for (int bj = 0; bj < 2; ++bj) { const int c = col0 + bj * HALF; if (c < ncols) { const f32x4 v0 = acc[ai][bj][m][0] * rs, v1 = acc[ai][bj][m][1] * rs;
                    u32x4 w; w.x = cvt_pk_bf16(v0[0], v0[1]); w.y = cvt_pk_bf16(v0[2], v0[3]); w.z = cvt_pk_bf16(v1[0], v1[1]); w.w = cvt_pk_bf16(v1[2], v1[3]);
                    *(u32x4*)(O + (size_t)r * ldo + c) = w; } } }
    }
};
struct EpiVt {
    bf16* Vt; const float* ssq;
    __device__ __forceinline__ void operator()(AccRef acc, const Unit& u, int wr, int wc, int fr, int fq) const {
        const int row0 = u.pm * BM + wr * 64 + fr, col0 = u.pn * BM + wc * 32 + 8 * fq;
#pragma unroll
        for (int bj = 0; bj < 2; ++bj) { const int c = col0 + bj * HALF;
            f32x4 s0, s1;
#pragma unroll
            for (int i = 0; i < 4; ++i) { s0[i] = rsqrtf(sum8(ssq + (size_t)(c + i) * 8) * (1.f / KVL) + EPS); s1[i] = rsqrtf(sum8(ssq + (size_t)(c + 4 + i) * 8) * (1.f / KVL) + EPS); }
            const int b = c >> 14, s = c & (SEQ - 1);
#pragma unroll
            for (int ai = 0; ai < 2; ++ai)
#pragma unroll
                for (int m = 0; m < 4; ++m) { const int r = row0 + ai * HALF + m * 16; const f32x4 v0 = acc[ai][bj][m][0] * s0, v1 = acc[ai][bj][m][1] * s1;
                    u32x4 w; w.x = cvt_pk_bf16(v0[0], v0[1]); w.y = cvt_pk_bf16(v0[2], v0[3]); w.z = cvt_pk_bf16(v1[0], v1[1]); w.w = cvt_pk_bf16(v1[2], v1[3]);
                    *(u32x4*)(Vt + ((((size_t)(b * NH + (r >> 6)) * (SEQ / 64) + (s >> 6)) * 64 + (r & 63)) * 64 + (s & 63))) = w; } }
    }
};
struct EpiMemKV {
    float* O; const float* ssq;
    __device__ __forceinline__ void operator()(AccRef acc, const Unit& u, int wr, int wc, int fr, int fq) const {
        const int row0 = u.pm * BM + wr * 64 + fr, col0 = u.pn * BM + wc * 32 + 8 * fq;
#pragma unroll
        for (int ai = 0; ai < 2; ++ai)
#pragma unroll
            for (int m = 0; m < 4; ++m) { const int r = row0 + ai * HALF + m * 16; const float rs = rsqrtf(ssq[r] * (1.f / DM) + EPS);
#pragma unroll
                for (int bj = 0; bj < 2; ++bj) { float* o = O + (size_t)r * 2048 + col0 + bj * HALF;
                    *(f32x4*)o = acc[ai][bj][m][0] * rs; *(f32x4*)(o + 4) = acc[ai][bj][m][1] * rs; } }
    }
};
}

__device__ __forceinline__ int rowmap(int mode, int n) {
    if (mode == 1) { const int hi = n >= FF, m = hi ? n - FF : n; return (m >> 7) * 256 + (hi ? 128 : 0) + (m & 127); }
    if (mode == 2) { const int h = n >> 7, r = n & 127; return (r < 64 ? 0 : 768) + h * 64 + (r & 63); }
    return n;
}
__device__ __forceinline__ void transpose_item(const float* __restrict__ W, int K, int N, const float* __restrict__ gain, bf16* WT, int mode, LAS float* scr, int item, int lane) {
    const int nblk = N / 32, kb = item / nblk, nb = item % nblk, k0 = 64 * kb, n0 = 32 * nb;
#pragma unroll
    for (int i = 0; i < 8; ++i) { const int kk = 8 * i + (lane >> 3), n4 = (lane & 7) * 4;
        f32x4 v = *(const f32x4*)(W + (size_t)(k0 + kk) * N + n0 + n4); if (gain) v = v * gain[k0 + kk];
        LAS float* d = scr + kk * 33 + n4; d[0] = v[0]; d[1] = v[1]; d[2] = v[2]; d[3] = v[3]; }
    asm volatile("s_waitcnt lgkmcnt(0)" ::: "memory");
    const int c = lane & 7;
#pragma unroll
    for (int j = 0; j < 4; ++j) { const int n = (lane >> 3) + 8 * j; const LAS float* s = scr + (8 * c) * 33 + n;
        u32x4 o; o.x = cvt_pk_bf16(s[0 * 33], s[1 * 33]); o.y = cvt_pk_bf16(s[2 * 33], s[3 * 33]); o.z = cvt_pk_bf16(s[4 * 33], s[5 * 33]); o.w = cvt_pk_bf16(s[6 * 33], s[7 * 33]);
        *(u32x4*)(WT + (size_t)rowmap(mode, n0 + n) * K + k0 + 8 * c) = o; }
    asm volatile("s_waitcnt lgkmcnt(0)" ::: "memory");
}
#define TJOB(W, K, N, GAIN, WT, MODE) do { const int _ni = ((K) / 64) * ((N) / 32); for (; it < _ni; it += 2 * NGW) { transpose_item((W), (K), (N), (GAIN), (WT), (MODE), scr, it, lane); if (it + NGW < _ni) transpose_item((W), (K), (N), (GAIN), (WT), (MODE), scr + 2112, it + NGW, lane); } if (it - NGW >= _ni) it -= NGW; it -= _ni; } while (0)

__device__ __forceinline__ void row_to_bf16_ssq(const float* xrow, bf16* orow, float* ssq_out, int nslots, int lane) {
    const f32x4* xr = (const f32x4*)xrow + lane; f32x4 v[4]; float s = 0.f;
#pragma unroll
    for (int j = 0; j < 4; ++j) { v[j] = xr[64 * j]; s += (v[j][0] * v[j][0] + v[j][1] * v[j][1]) + (v[j][2] * v[j][2] + v[j][3] * v[j][3]); }
    s = wave_sum(s);
    u32x2* o8 = (u32x2*)orow + lane;
#pragma unroll
    for (int j = 0; j < 4; ++j) { u32x2 w; w.x = cvt_pk_bf16(v[j][0], v[j][1]); w.y = cvt_pk_bf16(v[j][2], v[j][3]); o8[64 * j] = w; }
    if (lane < nslots) ssq_out[lane] = lane == 0 ? s : 0.f;
}

template <int D, bool ROPE, bool FIXED>
__device__ __forceinline__ void attn_core(LAS unsigned char* lds, const bf16* __restrict__ Q, int ldq, int qtok0, const float* __restrict__ qgain, const int* __restrict__ positions,
                                          const bf16* __restrict__ Kp, const bf16* __restrict__ Vt, int nkeys, bf16* O, int ldo, float qscale, float negb) {
    constexpr int NKS = D / 16, KSTR = D * 2 + 16, VSTR = 144, KBUF = 64 * KSTR, VBUF = 64 * VSTR, KCH = 64 * D * 2 / 16;
    int tid_ = threadIdx.x; asm volatile("" : "+v"(tid_));
    const int tid = tid_, wave = tid >> 6, lane = tid & 63, r32 = lane & 31, h = lane >> 5;
    constexpr int TBUF = KBUF + VBUF;
    const int kc0 = tid, kc1 = tid + 512;
    const bool has1 = kc1 < KCH;
    const int kl0 = (kc0 / (D / 8)) * KSTR + (kc0 % (D / 8)) * 16, kl1 = (kc1 / (D / 8)) * KSTR + (kc1 % (D / 8)) * 16;
    const int vdv = tid >> 3, vpart = tid & 7, vl = KBUF + vdv * VSTR + (vpart >> 1) * 32 + (vpart & 1) * 8;
    const bf16* vsrc = Vt + (size_t)vdv * 64 + vpart * 8;
    const int nt = nkeys / 64;
    u32x4 krA0, krA1 = {0, 0, 0, 0}, vrA, krB0, krB1 = {0, 0, 0, 0}, vrB;
#define ATT_LOAD(tt, k0_, k1_, v_) do { const bf16* kp_ = Kp + (size_t)(tt) * 64 * D; k0_ = *(const u32x4*)(kp_ + (size_t)kc0 * 8); if (has1) k1_ = *(const u32x4*)(kp_ + (size_t)kc1 * 8); v_ = *(const u32x4*)(vsrc + (size_t)(tt) * 4096); } while (0)
#define ATT_STORE(boff, k0_, k1_, v_) do { LAS unsigned char* b_ = lds + (boff); *(LAS u32x4*)(b_ + kl0) = k0_; if (has1) *(LAS u32x4*)(b_ + kl1) = k1_; \
        *(LAS u32x2*)(b_ + vl) = (u32x2){v_.x, v_.y}; *(LAS u32x2*)(b_ + vl + 16) = (u32x2){v_.z, v_.w}; } while (0)
#define ATT_QK(boff, d0, d1) do { const LAS unsigned char* Kb_ = lds + (boff) + r32 * KSTR + h * 16; \
        _Pragma("unroll") for (int j_ = 0; j_ < 16; ++j_) { d0[j_] = FIXED ? negb : 0.f; d1[j_] = FIXED ? negb : 0.f; } \
        _Pragma("unroll") for (int ks_ = 0; ks_ < NKS; ++ks_) { \
            const bf16x8 k0_ = *(const LAS bf16x8*)(Kb_ + ks_ * 32); const bf16x8 k1_ = *(const LAS bf16x8*)(Kb_ + 32 * KSTR + ks_ * 32); \
            d0 = __builtin_amdgcn_mfma_f32_32x32x16_bf16(k0_, qf[ks_], d0, 0, 0, 0); d1 = __builtin_amdgcn_mfma_f32_32x32x16_bf16(k1_, qf[ks_], d1, 0, 0, 0); } } while (0)
#define ATT_ITER(t, LK0, LK1, LV, SK0, SK1, SV) do { \
        { const int tn_ = ((t) + 3 < nt) ? (t) + 3 : nt - 1; ATT_LOAD(tn_, LK0, LK1, LV); } \
        f32x16 n0, n1; \
        __builtin_amdgcn_s_setprio(1); \
        ATT_QK(b1, n0, n1); \
        if constexpr (FIXED) {   \
            float ps = 0.f; \
            _Pragma("unroll") for (int j = 0; j < 16; ++j) { s0[j] = __builtin_amdgcn_exp2f(s0[j]); s1[j] = __builtin_amdgcn_exp2f(s1[j]); ps += s0[j] + s1[j]; } \
            lsum += ps; \
        } else { \
            float mx = fmaxf(s0[0], s1[0]); \
            _Pragma("unroll") for (int j = 1; j < 16; ++j) mx = fmaxf(mx, fmaxf(s0[j], s1[j])); \
            mx = fmaxf(mx, __shfl_xor(mx, 32)); \
            const float mnew = fmaxf(mrow, mx), alpha = __builtin_amdgcn_exp2f(mrow - mnew); mrow = mnew; \
            float ps = 0.f; \
            _Pragma("unroll") for (int j = 0; j < 16; ++j) { s0[j] = __builtin_amdgcn_exp2f(s0[j] - mnew); s1[j] = __builtin_amdgcn_exp2f(s1[j] - mnew); ps += s0[j] + s1[j]; } \
            lsum = lsum * alpha + ps; \
            _Pragma("unroll") for (int j = 0; j < 16; ++j) { o0[j] *= alpha; o1[j] *= alpha; } \
        } \
        bf16x8 p[4]; \
        { u32x4 w; \
          w.x = cvt_pk_bf16(s0[0], s0[1]); w.y = cvt_pk_bf16(s0[2], s0[3]); w.z = cvt_pk_bf16(s0[4], s0[5]); w.w = cvt_pk_bf16(s0[6], s0[7]); p[0] = __builtin_bit_cast(bf16x8, w); \
          w.x = cvt_pk_bf16(s0[8], s0[9]); w.y = cvt_pk_bf16(s0[10], s0[11]); w.z = cvt_pk_bf16(s0[12], s0[13]); w.w = cvt_pk_bf16(s0[14], s0[15]); p[1] = __builtin_bit_cast(bf16x8, w); \
          w.x = cvt_pk_bf16(s1[0], s1[1]); w.y = cvt_pk_bf16(s1[2], s1[3]); w.z = cvt_pk_bf16(s1[4], s1[5]); w.w = cvt_pk_bf16(s1[6], s1[7]); p[2] = __builtin_bit_cast(bf16x8, w); \
          w.x = cvt_pk_bf16(s1[8], s1[9]); w.y = cvt_pk_bf16(s1[10], s1[11]); w.z = cvt_pk_bf16(s1[12], s1[13]); w.w = cvt_pk_bf16(s1[14], s1[15]); p[3] = __builtin_bit_cast(bf16x8, w); } \
        const LAS unsigned char* Vb = lds + b0 + KBUF + r32 * VSTR + h * 16; \
        _Pragma("unroll") for (int kk = 0; kk < 4; ++kk) { \
            const bf16x8 vf0 = *(const LAS bf16x8*)(Vb + kk * 32); \
            const bf16x8 vf1 = *(const LAS bf16x8*)(Vb + 32 * VSTR + kk * 32); \
            o0 = __builtin_amdgcn_mfma_f32_32x32x16_bf16(vf0, p[kk], o0, 0, 0, 0); \
            o1 = __builtin_amdgcn_mfma_f32_32x32x16_bf16(vf1, p[kk], o1, 0, 0, 0); \
        } \
        __builtin_amdgcn_s_setprio(0); \
        ATT_STORE(b2, SK0, SK1, SV); \
        s0 = n0; s1 = n1; \
        { const int tmp = b0; b0 = b1; b1 = b2; b2 = tmp; } \
        __syncthreads(); \
    } while (0)
    ATT_LOAD(0, krA0, krA1, vrA);
    ATT_LOAD(1, krB0, krB1, vrB);
    bf16x8 qf[NKS];
    {
        const int qtok = qtok0 + wave * 32 + r32;
        float v[NKS][8]; float ss = 0.f;
#pragma unroll
        for (int ks = 0; ks < NKS; ++ks) { const u32x4 raw = *(const u32x4*)(Q + (size_t)qtok * ldq + ks * 16 + h * 8);
            v[ks][0] = bflo(raw.x); v[ks][1] = bfhi(raw.x); v[ks][2] = bflo(raw.y); v[ks][3] = bfhi(raw.y); v[ks][4] = bflo(raw.z); v[ks][5] = bfhi(raw.z); v[ks][6] = bflo(raw.w); v[ks][7] = bfhi(raw.w);
#pragma unroll
            for (int j = 0; j < 8; ++j) ss += v[ks][j] * v[ks][j]; }
        ss += __shfl_xor(ss, 32);
        const float rs = rsqrtf(ss * (1.f / D) + EPS);
#pragma unroll
        for (int ks = 0; ks < NKS; ++ks)
#pragma unroll
            for (int j = 0; j < 8; ++j) v[ks][j] *= rs * qgain[ks * 16 + h * 8 + j];
        if constexpr (ROPE) {
            const float pos = (float)positions[qtok];
#pragma unroll
            for (int j = 0; j < 8; ++j) { float s, c; sincos_big(pos * rope_inv_freq(h * 8 + j), s, c);
                const float x1 = v[4][j], x2 = v[5][j]; v[4][j] = x1 * c - x2 * s; v[5][j] = x2 * c + x1 * s; }
        }
#pragma unroll
        for (int ks = 0; ks < NKS; ++ks) { u32x4 w; w.x = cvt_pk_bf16(v[ks][0] * qscale, v[ks][1] * qscale); w.y = cvt_pk_bf16(v[ks][2] * qscale, v[ks][3] * qscale);
            w.z = cvt_pk_bf16(v[ks][4] * qscale, v[ks][5] * qscale); w.w = cvt_pk_bf16(v[ks][6] * qscale, v[ks][7] * qscale); qf[ks] = __builtin_bit_cast(bf16x8, w); }
    }
    __syncthreads();
    ATT_STORE(0, krA0, krA1, vrA);
    ATT_STORE(TBUF, krB0, krB1, vrB);
    { const int t2 = nt > 2 ? 2 : nt - 1; ATT_LOAD(t2, krB0, krB1, vrB); }
    __syncthreads();
    f32x16 o0, o1, s0, s1;
#pragma unroll
    for (int j = 0; j < 16; ++j) { o0[j] = 0.f; o1[j] = 0.f; }
    float mrow = -1e30f, lsum = 0.f;
    int b0 = 0, b1 = TBUF, b2 = 2 * TBUF;
    ATT_QK(b0, s0, s1);
    for (int t = 0; t < nt; t += 2) {
        ATT_ITER(t, krA0, krA1, vrA, krB0, krB1, vrB);
        ATT_ITER(t + 1, krB0, krB1, vrB, krA0, krA1, vrA);
    }
#undef ATT_ITER
#undef ATT_LOAD
#undef ATT_STORE
#undef ATT_QK
    lsum += __shfl_xor(lsum, 32);
    const float inv = 1.f / lsum;
    bf16* orow = O + (size_t)(qtok0 + wave * 32 + r32) * ldo;
#pragma unroll
    for (int g4 = 0; g4 < 4; ++g4) {
        u32x2 w; w.x = cvt_pk_bf16(o0[g4 * 4 + 0] * inv, o0[g4 * 4 + 1] * inv); w.y = cvt_pk_bf16(o0[g4 * 4 + 2] * inv, o0[g4 * 4 + 3] * inv);
        *(u32x2*)(orow + g4 * 8 + h * 4) = w;
        w.x = cvt_pk_bf16(o1[g4 * 4 + 0] * inv, o1[g4 * 4 + 1] * inv); w.y = cvt_pk_bf16(o1[g4 * 4 + 2] * inv, o1[g4 * 4 + 3] * inv);
        *(u32x2*)(orow + 32 + g4 * 8 + h * 4) = w;
    }
}

template <int D, bool ROPE>
__device__ __forceinline__ void attn_unit(LAS unsigned char* lds, const bf16* __restrict__ Q, int ldq, int qtok0, const float* __restrict__ qgain, const float* __restrict__ kgain, const int* __restrict__ positions,
                                          const bf16* __restrict__ Kp, const bf16* __restrict__ Vt, int nkeys, bf16* O, int ldo, float qscale) {
    float mq = 0.f, mk = 0.f;
    for (int i = 0; i < D; ++i) { mq = fmaxf(mq, fabsf(qgain[i])); mk = fmaxf(mk, fabsf(kgain[i])); }
    const float B = mq * mk * (float)D * qscale * 1.03f + 0.5f;
    if (B < 48.f) attn_core<D, ROPE, true>(lds, Q, ldq, qtok0, qgain, positions, Kp, Vt, nkeys, O, ldo, qscale, -B);
    else attn_core<D, ROPE, false>(lds, Q, ldq, qtok0, qgain, positions, Kp, Vt, nkeys, O, ldo, qscale, 0.f);
}

__device__ __forceinline__ int lds_byte3(int r, int c) { const int st = (r >> 4) * 3 + (c >> 5), rr = r & 15, cc = c & 31, ob = rr * 64 + cc * 2; return st * 1024 + (ob ^ (((ob >> 9) & 1) << 5)); }
__device__ __forceinline__ float gelu_tanh(float x) { const float z = x * (1.5957691216057308f + 0.07135481627260025f * x * x); return x * __builtin_amdgcn_rcpf(1.f + __builtin_amdgcn_exp2f(-1.4426950408889634f * z)); }
constexpr int LRU_XCB = 0, LRU_XCF = 12288, LRU_AB = 36864;
constexpr int LRU_CST = 135168;
__device__ __forceinline__ void lru_load_consts(LAS unsigned char* lds, int n, const float* __restrict__ conv_w, const float* __restrict__ conv_b, const float* __restrict__ gate_b, const float* __restrict__ sp) {
    int tid_ = threadIdx.x; asm volatile("" : "+v"(tid_));
    LAS float* C = (LAS float*)(lds + LRU_CST);
    for (int i = tid_; i < 1056; i += NTHR) { float v;
        if (i < 384) v = conv_w[(i / 96) * LRUW + n * 96 + i % 96];
        else if (i < 480) v = conv_b[n * 96 + (i - 384)];
        else if (i < 864) v = gate_b[((i - 480) / 96) * LRUW + n * 96 + (i - 480) % 96];
        else v = sp[((i - 864) / 96) * LRUW + n * 96 + (i - 864) % 96];
        C[i] = v; }
}
template <bool FINAL>
__device__ __forceinline__ void lru_item(LAS unsigned char* lds, int item, const bf16* __restrict__ U, const float* __restrict__ conv_w, const float* __restrict__ conv_b,
                                         const bf16* __restrict__ WgT, const float* __restrict__ gate_b, const float* __restrict__ lam,
                                         float* Pbuf, float* Hend, const float* __restrict__ carry, bf16* MIX) {
    int tid_ = threadIdx.x; asm volatile("" : "+v"(tid_));
    const int tid = tid_, wave = tid >> 6, lane = tid & 63;
    const int n = item & 7, c = (item >> 3) & 255, b = item >> 11, t0 = c * 64;
    LAS unsigned char* XCB = lds + LRU_XCB; LAS float* XCF = (LAS float*)(lds + LRU_XCF); LAS float* AB = (LAS float*)(lds + LRU_AB); const LAS float* CST = (const LAS float*)(lds + LRU_CST);
    for (int task = tid; task < 768; task += NTHR) {
        const int t = task / 12, c8 = (task % 12) * 8, gc = n * 96 + c8;
        float acc[8];
        { const f32x4 b0 = *(const LAS f32x4*)(CST + 384 + c8), b1 = *(const LAS f32x4*)(CST + 384 + c8 + 4);
          acc[0] = b0[0]; acc[1] = b0[1]; acc[2] = b0[2]; acc[3] = b0[3]; acc[4] = b1[0]; acc[5] = b1[1]; acc[6] = b1[2]; acc[7] = b1[3]; }
#pragma unroll
        for (int j = 0; j < 4; ++j) { const int s = t0 + t + j - 2;
            if (s >= 0 && s < SEQ) { const u32x4 raw = *(const u32x4*)(U + (size_t)(b * SEQ + s) * LRU_IN + LRUW + gc);
                const f32x4 w0 = *(const LAS f32x4*)(CST + j * 96 + c8), w1 = *(const LAS f32x4*)(CST + j * 96 + c8 + 4);
                acc[0] += w0[0] * bflo(raw.x); acc[1] += w0[1] * bfhi(raw.x); acc[2] += w0[2] * bflo(raw.y); acc[3] += w0[3] * bfhi(raw.y);
                acc[4] += w1[0] * bflo(raw.z); acc[5] += w1[1] * bfhi(raw.z); acc[6] += w1[2] * bflo(raw.w); acc[7] += w1[3] * bfhi(raw.w); } }
        *(LAS f32x4*)(XCF + t * 96 + c8) = (f32x4){acc[0], acc[1], acc[2], acc[3]}; *(LAS f32x4*)(XCF + t * 96 + c8 + 4) = (f32x4){acc[4], acc[5], acc[6], acc[7]};
        u32x4 w; w.x = cvt_pk_bf16(acc[0], acc[1]); w.y = cvt_pk_bf16(acc[2], acc[3]); w.z = cvt_pk_bf16(acc[4], acc[5]); w.w = cvt_pk_bf16(acc[6], acc[7]);
        *(LAS u32x4*)(XCB + lds_byte3(t, c8)) = w;
    }
    __syncthreads();
    {
        const int dir = wave & 1, mp = (wave >> 1) & 1, nh = wave >> 2, fr = lane & 15, fq = lane >> 4;
        bf16x8 af[2][3];
#pragma unroll
        for (int mm = 0; mm < 2; ++mm)
#pragma unroll
            for (int ks = 0; ks < 3; ++ks) af[mm][ks] = *(const LAS bf16x8*)(XCB + lds_byte3((mp * 2 + mm) * 16 + fr, ks * 32 + fq * 8));
        f32x4 acc[2][3][2];
#pragma unroll
        for (int g = 0; g < 2; ++g)
#pragma unroll
            for (int nl = 0; nl < 3; ++nl) { acc[g][nl][0] = (f32x4){0.f, 0.f, 0.f, 0.f}; acc[g][nl][1] = (f32x4){0.f, 0.f, 0.f, 0.f};
                const bf16* wp = WgT + ((size_t)(((dir * 2 + g) * 8 + n) * 96 + (nh * 3 + nl) * 16 + fr)) * 96 + fq * 8;
#pragma unroll
                for (int ks = 0; ks < 3; ++ks) { const bf16x8 bfr = *(const bf16x8*)(wp + ks * 32);
                    acc[g][nl][0] = __builtin_amdgcn_mfma_f32_16x16x32_bf16(af[0][ks], bfr, acc[g][nl][0], 0, 0, 0);
                    acc[g][nl][1] = __builtin_amdgcn_mfma_f32_16x16x32_bf16(af[1][ks], bfr, acc[g][nl][1], 0, 0, 0); } }
#pragma unroll
        for (int nl = 0; nl < 3; ++nl) { const int ch = (nh * 3 + nl) * 16 + fr, gc = n * 96 + ch;
            const float br = CST[480 + (dir * 2 + 0) * 96 + ch], bi = CST[480 + (dir * 2 + 1) * 96 + ch];
            const float sp = CST[864 + dir * 96 + ch];
#pragma unroll
            for (int mm = 0; mm < 2; ++mm)
#pragma unroll
            for (int i = 0; i < 4; ++i) { const int t = (mp * 2 + mm) * 16 + fq * 4 + i;
                const float r = sigmoidf_(acc[0][nl][mm][i] + br), ig = sigmoidf_(acc[1][nl][mm][i] + bi);
                const float la = -8.f * r * sp, a = __expf(la), x2 = 2.f * la;
                const float em1 = (x2 > -0.02f) ? x2 * (1.f + x2 * (0.5f + x2 * (1.f / 6.f))) : (a * a - 1.f);
                const float bb = __builtin_amdgcn_sqrtf(fmaxf(-em1, 0.f)) * ig * XCF[t * 96 + ch];
                *(LAS f32x2_t*)(AB + ((dir * 64 + t) * 96 + ch) * 2) = (f32x2_t){a, bb}; } }
    }
    __syncthreads();
    if (tid < 192) {
        const int dir = tid / 96, ch = tid % 96, gc = n * 96 + ch;
        const size_t cidx = ((size_t)((b * 2 + dir) * 256 + c)) * LRUW + gc;
        float hst = FINAL ? carry[cidx] : 0.f, P = 1.f;
        LAS float* Ab = AB + (dir * 64 * 96 + ch) * 2;
        for (int s8 = 0; s8 < 8; ++s8) {
            float av[8], bv[8];
#pragma unroll
            for (int j = 0; j < 8; ++j) { const int st = s8 * 8 + j, t = dir ? 63 - st : st; const f32x2_t ab = *(const LAS f32x2_t*)(Ab + t * 192); av[j] = ab[0]; bv[j] = ab[1]; }
#pragma unroll
            for (int j = 0; j < 8; ++j) { hst = av[j] * hst + bv[j]; if (FINAL) bv[j] = hst; else P *= av[j]; }
            if (FINAL) {
#pragma unroll
                for (int j = 0; j < 8; ++j) { const int st = s8 * 8 + j, t = dir ? 63 - st : st; Ab[t * 192 + 1] = bv[j]; } }
        }
        if (!FINAL) { Hend[cidx] = hst; Pbuf[cidx] = P; }
    }
    __syncthreads();
    if (FINAL) {
        for (int task = tid; task < 768; task += NTHR) {
            const int t = task / 12, c8 = (task % 12) * 8, gc = n * 96 + c8;
            const size_t tok = (size_t)(b * SEQ + t0 + t);
            const u32x4 raw = *(const u32x4*)(U + tok * LRU_IN + gc);
            const LAS float* h0 = AB + ((0 * 64 + t) * 96 + c8) * 2; const LAS float* h1 = AB + ((1 * 64 + t) * 96 + c8) * 2;
            const f32x4 p0 = *(const LAS f32x4*)h0, p1 = *(const LAS f32x4*)(h0 + 4), p2 = *(const LAS f32x4*)(h0 + 8), p3 = *(const LAS f32x4*)(h0 + 12);
            const f32x4 q0 = *(const LAS f32x4*)h1, q1 = *(const LAS f32x4*)(h1 + 4), q2 = *(const LAS f32x4*)(h1 + 8), q3 = *(const LAS f32x4*)(h1 + 12);
            float o[8];
            o[0] = (p0[1] + q0[1]) * gelu_tanh(bflo(raw.x)); o[1] = (p0[3] + q0[3]) * gelu_tanh(bfhi(raw.x));
            o[2] = (p1[1] + q1[1]) * gelu_tanh(bflo(raw.y)); o[3] = (p1[3] + q1[3]) * gelu_tanh(bfhi(raw.y));
            o[4] = (p2[1] + q2[1]) * gelu_tanh(bflo(raw.z)); o[5] = (p2[3] + q2[3]) * gelu_tanh(bfhi(raw.z));
            o[6] = (p3[1] + q3[1]) * gelu_tanh(bflo(raw.w)); o[7] = (p3[3] + q3[3]) * gelu_tanh(bfhi(raw.w));
            u32x4 w; w.x = cvt_pk_bf16(o[0], o[1]); w.y = cvt_pk_bf16(o[2], o[3]); w.z = cvt_pk_bf16(o[4], o[5]); w.w = cvt_pk_bf16(o[6], o[7]);
            *(u32x4*)(MIX + tok * DM + gc) = w;
        }
        __syncthreads();
    }
}


#define XB_TMO      128
#define XB_XCNT(j)  (256  + 64 * (j))
#define XB_XSUB(j)  (1280 + 64 * (j))
#define XB_XGEN(j)  (2304 + 64 * (j))
#define XB_TOP      3328
#define XB_TOPGEN   3392
#define XCD_BAR_WORDS 3456
#define XB_SPIN_CAP (1u << 20)
__device__ __forceinline__ unsigned xb_ld(unsigned* p)              { return __hip_atomic_load(p, __ATOMIC_RELAXED, __HIP_MEMORY_SCOPE_AGENT); }
__device__ __forceinline__ unsigned xb_add(unsigned* p, unsigned v) { return __hip_atomic_fetch_add(p, v, __ATOMIC_RELAXED, __HIP_MEMORY_SCOPE_AGENT); }
__device__ __forceinline__ unsigned xb_xcc_id() { return (unsigned)__builtin_amdgcn_s_getreg((3 << 11) | 20) & 0xFu; }
#define XB_SPIN(cond, bar) do { unsigned _sp = 0; while (cond) { __builtin_amdgcn_s_sleep(1); \
    if ((++_sp & 255u) == 0u) { if (xb_ld(&(bar)[XB_TMO])) break; if (_sp > XB_SPIN_CAP) { atomicAdd(&(bar)[XB_TMO], 1u); break; } } } } while (0)
__device__ __forceinline__ void xcd_barrier_complete(unsigned* bar, unsigned x, unsigned& nloc, unsigned& nx) {
    const unsigned G = gridDim.x * gridDim.y * gridDim.z;
    unsigned sum, cnt, mine, sp = 0u;
    for (;;) {
        sum = 0u; cnt = 0u; mine = 0u;
#pragma unroll
        for (unsigned j = 0; j < 16; ++j) { const unsigned c = xb_ld(&bar[XB_XCNT(j)]); sum += c; cnt += (c > 0u) ? 1u : 0u; mine = (j == x) ? c : mine; }
        if (sum == G) break;
        __builtin_amdgcn_s_sleep(1);
        if ((++sp & 255u) == 0u) { if (xb_ld(&bar[XB_TMO])) break; if (sp > XB_SPIN_CAP) { atomicAdd(&bar[XB_TMO], 1u); break; } }
    }
    nloc = mine > 0u ? mine : 1u; nx = cnt > 0u ? cnt : 1u;
}
__device__ __forceinline__ void xcd_barrier(unsigned* bar, volatile LAS unsigned* st) {
    asm volatile("s_waitcnt vmcnt(0)" ::: "memory");
    __syncthreads();
    if (threadIdx.x == 0) {
        const unsigned x = xb_xcc_id();
        __builtin_amdgcn_s_waitcnt(0);
        unsigned nloc = st[0], nx = st[1];
        if (nloc == 0u) { xcd_barrier_complete(bar, x, nloc, nx); st[0] = nloc; st[1] = nx; }
        const unsigned old = xb_add(&bar[XB_XSUB(x)], 1u);
        const unsigned gen = old / nloc;
        if (old + 1u == (gen + 1u) * nloc) {
            __builtin_amdgcn_fence(__ATOMIC_RELEASE, "agent");
            asm volatile("s_waitcnt vmcnt(0)" ::: "memory");
            const unsigned og = xb_add(&bar[XB_TOP], 1u);
            const unsigned tg = og / nx;
            if (og + 1u == (tg + 1u) * nx) xb_add(&bar[XB_TOPGEN], 1u);
            else XB_SPIN(xb_ld(&bar[XB_TOPGEN]) == tg, bar);
            __builtin_amdgcn_fence(__ATOMIC_ACQUIRE, "agent");
            xb_add(&bar[XB_XGEN(x)], 1u);
            asm volatile("s_waitcnt vmcnt(0)" ::: "memory");
        } else {
            XB_SPIN(xb_ld(&bar[XB_XGEN(x)]) == gen, bar);
            __builtin_amdgcn_fence(__ATOMIC_ACQUIRE, "agent");
            asm volatile("s_waitcnt vmcnt(0)" ::: "memory");
        }
    }
    __syncthreads();
}

struct Params { const void* in[28]; float* out; unsigned char* ws; };
__device__ __forceinline__ void* kload(int i) {
    const __attribute__((address_space(4))) char* ka = (const __attribute__((address_space(4))) char*)__builtin_amdgcn_kernarg_segment_ptr();
    asm volatile("" : "+s"(ka));
    return *(void* const __attribute__((address_space(4)))*)(ka + 8 * i);
}

__global__ void __launch_bounds__(NTHR, 2) mega_fwd(Params p) {
    extern __shared__ __attribute__((aligned(16))) unsigned char lds_raw[];
    LAS unsigned char* lds = (LAS unsigned char*)lds_raw;
    cg::grid_group grid = cg::this_grid();
    const int G = gridDim.x, bx = blockIdx.x, NGW = G * NWAVES;
    volatile LAS unsigned* const bar_st = (volatile LAS unsigned*)(lds + (LDS_BYTES - 64));
    if (threadIdx.x < 2) bar_st[threadIdx.x] = 0u;
    if (threadIdx.x == 0) (void)xb_add(&((unsigned*)(kload(29)) + OFF_BAR / 4)[XB_XCNT(xb_xcc_id())], 1u);
    __syncthreads();
#define GRID_BAR() xcd_barrier((unsigned*)(WSB + OFF_BAR), bar_st)
#define FRESH_IDS int tid_f = threadIdx.x; asm volatile("" : "+v"(tid_f)); const int tid = tid_f, lane = tid & 63, wave = __builtin_amdgcn_readfirstlane(tid >> 6), gw = bx * NWAVES + wave; LAS float* scr = (LAS float*)(lds + wave * 16896); (void)scr; (void)gw; (void)lane; (void)tid;
#define KARG(i) (kload(i))
#define WSB ((unsigned char*)kload(29))
#define x_in ((const float*)KARG(0))
#define mem ((const float*)KARG(1))
#define positions ((const int*)KARG(2))
#define ffn1_norm ((const float*)KARG(3))
#define ffn1_gu ((const float*)KARG(4))
#define ffn1_dn ((const float*)KARG(5))
#define mix_norm ((const float*)KARG(6))
#define mem_norm ((const float*)KARG(7))
#define w_mem_kv ((const float*)KARG(8))
#define mem_q_norm ((const float*)KARG(9))
#define mem_k_norm ((const float*)KARG(10))
#define w_out ((const float*)KARG(11))
#define ffn2_norm ((const float*)KARG(12))
#define ffn2_gu ((const float*)KARG(13))
#define ffn2_dn ((const float*)KARG(14))
#define lru_w_in ((const float*)KARG(15))
#define lru_conv_w ((const float*)KARG(16))
#define lru_conv_b ((const float*)KARG(17))
#define lru_gate_w ((const float*)KARG(18))
#define lru_gate_b ((const float*)KARG(19))
#define lru_lambda ((const float*)KARG(20))
#define mla_w_in ((const float*)KARG(21))
#define mla_q_a_norm ((const float*)KARG(22))
#define mla_w_uq ((const float*)KARG(23))
#define mla_kv_a_norm ((const float*)KARG(24))
#define mla_w_ukv ((const float*)KARG(25))
#define mla_q_norm ((const float*)KARG(26))
#define mla_k_norm ((const float*)KARG(27))
#define xout ((float*)KARG(28))
#define SSQ ((float*)(WSB + OFF_SSQ))
#define SSQC ((float*)(WSB + OFF_SSQC))
#define SSQM ((float*)(WSB + OFF_SSQM))
#define SPB ((float*)(WSB + OFF_SPB))
#define PBUF ((float*)(WSB + OFF_PBUF))
#define HEND ((float*)(WSB + OFF_HEND))
#define CARRY ((float*)(WSB + OFF_CARRY))
#define MKV ((float*)(WSB + OFF_MKV))
#define MEMK ((bf16*)(WSB + OFF_MEMK))
#define MEMVT ((bf16*)(WSB + OFF_MEMVT))
#define MEMB ((bf16*)(WSB + OFF_MEMB))
#define WGT ((bf16*)(WSB + OFF_WGT))
#define WMEM ((bf16*)(WSB + OFF_WMEM))
#define WOUT ((bf16*)(WSB + OFF_WOUT))
#define WIN ((bf16*)(WSB + OFF_WIN))
#define WUQ ((bf16*)(WSB + OFF_WUQ))
#define WKV ((bf16*)(WSB + OFF_WKV))
#define WGU1 ((bf16*)(WSB + OFF_WGU1))
#define WD1 ((bf16*)(WSB + OFF_WD1))
#define WGU2 ((bf16*)(WSB + OFF_WGU2))
#define WD2 ((bf16*)(WSB + OFF_WD2))
#define XB ((bf16*)(WSB + OFF_XB))
#define VT ((bf16*)(WSB + OFF_XB))
#define HB ((bf16*)(WSB + OFF_H))
#define UB ((bf16*)(WSB + OFF_H))
#define KN ((bf16*)(WSB + OFF_H + 64 * MiB))
#define MIX ((bf16*)(WSB + OFF_H + 112 * MiB))
#define QRAW ((bf16*)(WSB + OFF_QRAW))
#define KH ((bf16*)(WSB + OFF_KH))

    for (int rep_ = 0; rep_ < PROBE_SMALL_REPS; ++rep_) if (PH_MASK & 1) {
        FRESH_IDS
        int it = gw;
        TJOB(ffn1_gu, DM, NGU, ffn1_norm, WGU1, 1);
        TJOB(ffn1_dn, FF, DM, (const float*)nullptr, WD1, 0);
        for (int j = 0; j < 2; ++j) {
            TJOB(lru_w_in + (size_t)j * DM * LRU_IN, DM, LRU_IN, mix_norm + (2 * j) * DM, WIN + (size_t)j * LRU_IN * DM, 0);
            TJOB(mla_w_in + (size_t)j * DM * MLA_IN, DM, MLA_IN, mix_norm + (2 * j + 1) * DM, WIN + (size_t)2 * LRU_IN * DM + (size_t)j * MLA_INP * DM, 0);
            TJOB(mla_w_uq + (size_t)j * QL * NQ, QL, NQ, mla_q_a_norm + j * QL, WUQ + (size_t)j * NQP * QL, 0);
            TJOB(mla_w_ukv + (size_t)j * KVL * 1536, KVL, 1536, mla_kv_a_norm + j * KVL, WKV + (size_t)j * 1536 * KVL, 2);
        }
        for (int l = 0; l < NLAYERS_RUN; ++l) {
            TJOB(w_out + (size_t)l * DM * DM, DM, DM, (const float*)nullptr, WOUT + (size_t)l * DM * DM, 0);
            TJOB(w_mem_kv + (size_t)l * DM * 512, DM, 512, mem_norm + l * DM, WMEM + (size_t)l * 512 * DM, 0);
        }
        const int gt = bx * NTHR + tid, NGT = G * NTHR;
        for (int j = 0; j < 2; ++j) {
            u32x4* z1 = (u32x4*)(WIN + (size_t)2 * LRU_IN * DM + (size_t)j * MLA_INP * DM + (size_t)MLA_IN * DM);
            for (int i = gt; i < (MLA_INP - MLA_IN) * DM / 8; i += NGT) z1[i] = (u32x4){0, 0, 0, 0};
            u32x4* z2 = (u32x4*)(WUQ + (size_t)j * NQP * QL + (size_t)NQ * QL);
            for (int i = gt; i < (NQP - NQ) * QL / 8; i += NGT) z2[i] = (u32x4){0, 0, 0, 0};
        }
        { bf16* const wgt = WGT; const float* const gwp = lru_gate_w;
          for (int i = gt; i < 2 * 2 * 2 * 8 * 96 * 96; i += NGT) { const int k = i % 96, j = (i / 96) % 96, blk = i / 9216; wgt[i] = (bf16)(cvt_pk_bf16(gwp[(size_t)blk * 9216 + k * 96 + j], 0.f) & 0xffffu); } }
        { float* const sq = SSQ;
          { float* const spb = SPB; const float* const lmp = lru_lambda; for (int i = gt; i < 2 * 2 * LRUW; i += NGT) spb[i] = log1pf(__expf(-lmp[i])); }
          const float* const xi = x_in; bf16* const xb = XB;
#pragma unroll 4
          for (int m = gw; m < MTOK; m += NGW) row_to_bf16_ssq(xi + (size_t)m * DM, xb + (size_t)m * DM, sq + (size_t)m * 16, 16, lane);
          const float* const mi = mem; bf16* const mb = MEMB; float* const sqm = SSQM;
          for (int m = gw; m < BATCH * MEML; m += NGW) row_to_bf16_ssq(mi + (size_t)m * DM, mb + (size_t)m * DM, sqm + m, 1, lane); }
    }
    grid.sync(); if (PROBE_SYNC2) grid.sync();

    for (int l = 0; l < NLAYERS_RUN; ++l) {
        const int j2 = l >> 1; const bool is_lru = (l & 1) == 0;
        {
            pg8::Gemm g{XB, WGU1, DM, DM, MTOK, NGU, DM}; pg8::StaticOrder S; S.init(g.M, g.N, G, bx);
            pg8::EpiSwiglu E{HB, SSQ + (size_t)(3 * l) * MTOK * 16}; for (int rep_ = 0; rep_ < PROBE_GU_REPS; ++rep_) if ((PH_MASK & 2) && (GM_MASK & 2)) pg8::gemm_phase(lds, g, S, E);
        }
        GRID_BAR(); if (PROBE_SYNC2) GRID_BAR();
        {
            pg8::Gemm g{HB, WD1, FF, FF, MTOK, DM, FF}; pg8::StaticOrder S; S.init(g.M, g.N, G, bx);
            pg8::EpiRes E{l == 0 ? x_in : xout, xout, XB, SSQ + (size_t)(3 * l + 1) * MTOK * 16, 0.5f}; if ((PH_MASK & 2) && (GM_MASK & 4)) pg8::gemm_phase(lds, g, S, E);
        }
        GRID_BAR(); if (PROBE_SYNC2) GRID_BAR();
        {
            const int N = is_lru ? LRU_IN : MLA_INP;
            const bf16* Wt = is_lru ? WIN + (size_t)j2 * LRU_IN * DM : WIN + (size_t)2 * LRU_IN * DM + (size_t)j2 * MLA_INP * DM;
            pg8::Gemm g{XB, Wt, DM, DM, MTOK, N, DM}; pg8::StaticOrder S; S.init(g.M, g.N, G, bx);
            pg8::EpiU E{UB, N, SSQ + (size_t)(3 * l + 1) * MTOK * 16, SSQC + (size_t)(2 * j2) * MTOK * 8, SSQC + (size_t)(2 * j2 + 1) * MTOK * 8, is_lru ? 0 : 1};
            if ((PH_MASK & 2) && (GM_MASK & 8)) pg8::gemm_phase(lds, g, S, E);
            if (l == 0) {
                const int off = (G == 256) ? 128 : 0;
                if (bx >= off) { pg8::Gemm g2{MEMB, WMEM, DM, DM, BATCH * MEML, 2048, DM}; pg8::StaticOrder S2; S2.init(g2.M, g2.N, G - off, bx - off);
                    pg8::EpiMemKV E2{MKV, SSQM}; if ((PH_MASK & 2) && (GM_MASK & 1)) pg8::gemm_phase(lds, g2, S2, E2); }
            }
            for (int rep_ = 0; rep_ < PROBE_SMALL_REPS; ++rep_) {
            FRESH_IDS
            int it = gw;
            TJOB(ffn2_gu + (size_t)l * DM * NGU, DM, NGU, ffn2_norm + l * DM, WGU2, 1);
            TJOB(ffn2_dn + (size_t)l * FF * DM, FF, DM, (const float*)nullptr, WD2, 0);
            if (l < 3) {
                TJOB(ffn1_gu + (size_t)(l + 1) * DM * NGU, DM, NGU, ffn1_norm + (l + 1) * DM, WGU1, 1);
                TJOB(ffn1_dn + (size_t)(l + 1) * FF * DM, FF, DM, (const float*)nullptr, WD1, 0);
            }
            }
        }
        GRID_BAR(); if (PROBE_SYNC2) GRID_BAR();
        if (is_lru) {
            const float* cw = lru_conv_w + (size_t)j2 * 4 * LRUW; const float* cb = lru_conv_b + (size_t)j2 * LRUW;
            const bf16* wg = WGT + (size_t)j2 * 32 * 9216; const float* gb = lru_gate_b + (size_t)j2 * 4 * LRUW; const float* lm = SPB + (size_t)j2 * 2 * LRUW;
            for (int rep_ = 0; rep_ < PROBE_SMALL_REPS; ++rep_) if (l == 0) {
            FRESH_IDS
            const float* const mkv = MKV; const float* const mkn = mem_k_norm; bf16* const memk = MEMK; bf16* const memvt = MEMVT;
            for (int row = gw; row < 4 * 2 * 4 * 256; row += NGW) {
                const int m = row & 255, hh = (row >> 8) & 3, bb = (row >> 10) & 1, ll = row >> 11;
                const float* src = mkv + (size_t)(bb * 256 + m) * 2048 + ll * 512 + hh * 64 + lane;
                const float kraw = src[0], vraw = src[256];
                const float ss = wave_sum(kraw * kraw);
                const float kn = kraw * rsqrtf(ss * (1.f / 64) + EPS) * mkn[ll * 64 + lane];
                const size_t base = (size_t)((ll * 2 + bb) * 4 + hh);
                memk[(base * 256 + m) * 64 + lane] = (bf16)(cvt_pk_bf16(kn, 0.f) & 0xffffu);
                memvt[((base * 4 + (m >> 6)) * 64 + lane) * 64 + (m & 63)] = (bf16)(cvt_pk_bf16(vraw, 0.f) & 0xffffu);
            }
        }
            for (int rep_ = 0; rep_ < PROBE_LRU_REPS; ++rep_) if (PH_MASK & 4) { int cur_n = -1; for (int item = bx; item < 4096; item += G) { if ((item & 7) != cur_n) { cur_n = item & 7; __syncthreads(); lru_load_consts(lds, cur_n, cw, cb, gb, lm); __syncthreads(); } lru_item<false>(lds, item, UB, cw, cb, wg, gb, lm, PBUF, HEND, CARRY, MIX); } }
            GRID_BAR(); if (PROBE_SYNC2) GRID_BAR();
            for (int rep_ = 0; rep_ < PROBE_SMALL_REPS; ++rep_) { FRESH_IDS if (wave == 0 && bx < 48) {
                const int gid = bx * 64 + lane, ch = gid % LRUW, bd = gid / LRUW, dir = bd & 1;
                const float* const pbuf = PBUF; const float* const hend = HEND; float* const carry = CARRY;
                float hst = 0.f;
                for (int s8 = 0; s8 < 32; ++s8) {
                    float pv[8], hv[8];
#pragma unroll
                    for (int j = 0; j < 8; ++j) { const int st = s8 * 8 + j, c = dir ? 255 - st : st; const size_t idx = ((size_t)(bd * 256 + c)) * LRUW + ch; pv[j] = pbuf[idx]; hv[j] = hend[idx]; }
#pragma unroll
                    for (int j = 0; j < 8; ++j) { const int st = s8 * 8 + j, c = dir ? 255 - st : st; carry[((size_t)(bd * 256 + c)) * LRUW + ch] = hst; hst = pv[j] * hst + hv[j]; }
                }
            } }
            GRID_BAR(); if (PROBE_SYNC2) GRID_BAR();
            for (int rep_ = 0; rep_ < PROBE_LRU_REPS; ++rep_) if (PH_MASK & 8) { int cur_n = -1; for (int item = bx; item < 4096; item += G) { if ((item & 7) != cur_n) { cur_n = item & 7; __syncthreads(); lru_load_consts(lds, cur_n, cw, cb, gb, lm); __syncthreads(); } lru_item<true>(lds, item, UB, cw, cb, wg, gb, lm, PBUF, HEND, CARRY, MIX); } }
        } else {
            float* ssq_cq = SSQC + (size_t)(2 * j2) * MTOK * 8; float* ssq_ckv = SSQC + (size_t)(2 * j2 + 1) * MTOK * 8;
            {
                pg8::Gemm g{UB, WUQ + (size_t)j2 * NQP * QL, MLA_INP, QL, MTOK, NQP, QL}; pg8::StaticOrder S; S.init(g.M, g.N, G, bx);
                pg8::EpiRowScale E{QRAW, NQ, NQ, ssq_cq, 1.f / QL}; if ((PH_MASK & 2) && (GM_MASK & 16)) pg8::gemm_phase(lds, g, S, E);
            }
            {
                pg8::Gemm g{UB + QL, WKV + (size_t)j2 * 1536 * KVL, MLA_INP, KVL, MTOK, 768, KVL}; pg8::StaticOrder S; S.init(g.M, g.N, G, bx);
                pg8::EpiRowScale E{KN, 768, 768, ssq_ckv, 1.f / KVL}; if ((PH_MASK & 2) && (GM_MASK & 32)) pg8::gemm_phase(lds, g, S, E);
            }
            {
                pg8::Gemm g{WKV + (size_t)j2 * 1536 * KVL + (size_t)768 * KVL, UB + QL, KVL, MLA_INP, 768, MTOK, KVL}; pg8::StaticOrder S; S.init(g.M, g.N, G, bx);
                pg8::EpiVt E{VT, ssq_ckv}; if ((PH_MASK & 2) && (GM_MASK & 64)) pg8::gemm_phase(lds, g, S, E);
            }
            GRID_BAR(); if (PROBE_SYNC2) GRID_BAR();
            for (int rep_ = 0; rep_ < PROBE_SMALL_REPS; ++rep_) if (PH_MASK & 16) {
                FRESH_IDS
                const float* kg = mla_k_norm + j2 * DQK;
                const int hg = lane >> 4, l16 = lane & 15;
                const f32x4 kgn = *(const f32x4*)(kg + l16 * 4); const float kg1 = kg[64 + l16], kg2 = kg[80 + l16];
                const float invf = rope_inv_freq(l16);
                const bf16* const ub = UB; const bf16* const kn_ = KN; bf16* const kh = KH; const int* const posp = positions;
#pragma unroll 4
                for (int tok = gw; tok < MTOK; tok += NGW) {
                    const int b = tok >> 14, s = tok & (SEQ - 1);
                    const float x1 = bf2f(ub[(size_t)tok * MLA_INP + 640 + l16]), x2 = bf2f(ub[(size_t)tok * MLA_INP + 656 + l16]);
                    float sn, cs; sincos_big((float)posp[tok] * invf, sn, cs);
#pragma unroll
                    for (int pss = 0; pss < 3; ++pss) { const int head = pss * 4 + hg;
                        const u32x2 raw = *(const u32x2*)(kn_ + (size_t)tok * 768 + head * 64 + l16 * 4);
                        const float n0 = bflo(raw.x), n1 = bfhi(raw.x), n2 = bflo(raw.y), n3 = bfhi(raw.y);
                        float ss = (n0 * n0 + n1 * n1) + (n2 * n2 + n3 * n3) + (x1 * x1 + x2 * x2);
                        ss += __shfl_xor(ss, 1); ss += __shfl_xor(ss, 2); ss += __shfl_xor(ss, 4); ss += __shfl_xor(ss, 8);
                        const float rs = rsqrtf(ss * (1.f / DQK) + EPS);
                        bf16* dst = kh + ((size_t)(b * NH + head) * SEQ + s) * DQK;
                        u32x2 w; w.x = cvt_pk_bf16(n0 * rs * kgn[0], n1 * rs * kgn[1]); w.y = cvt_pk_bf16(n2 * rs * kgn[2], n3 * rs * kgn[3]);
                        *(u32x2*)(dst + l16 * 4) = w;
                        const float y1 = x1 * rs * kg1, y2 = x2 * rs * kg2;
                        const unsigned pr = cvt_pk_bf16(y1 * cs - y2 * sn, y2 * cs + y1 * sn);
                        dst[64 + l16] = (bf16)(pr & 0xffffu); dst[80 + l16] = (bf16)(pr >> 16);
                    }
                }
            }
            GRID_BAR(); if (PROBE_SYNC2) GRID_BAR();
            for (int rep_ = 0; rep_ < PROBE_ATTN_REPS; ++rep_) if (PH_MASK & 32) {
                const float qs = 0.10206207261596577f * 1.4426950408889634f;
                const float* qg = mla_q_norm + j2 * DQK; const float* kgp = mla_k_norm + j2 * DQK;
                if ((G & 7) == 0) {
                    const int xcd = bx & 7, jj = bx >> 3, nper = G >> 3;
                    for (int li = jj; li < 192; li += nper) { const int bh = xcd + 8 * (li >> 6), qb = li & 63, b = bh / NH, hh = bh % NH;
                        attn_unit<96, true>(lds, QRAW + hh * DQK, NQ, b * SEQ + qb * 256, qg, kgp, positions, KH + (size_t)bh * SEQ * DQK, VT + (size_t)bh * DV * SEQ, SEQ, MIX + hh * DV, DM, qs); }
                } else {
                    for (int un = bx; un < 1536; un += G) { const int bh = un >> 6, qb = un & 63, b = bh / NH, hh = bh % NH;
                        attn_unit<96, true>(lds, QRAW + hh * DQK, NQ, b * SEQ + qb * 256, qg, kgp, positions, KH + (size_t)bh * SEQ * DQK, VT + (size_t)bh * DV * SEQ, SEQ, MIX + hh * DV, DM, qs); }
                }
            }
        }
        for (int rep_ = 0; rep_ < PROBE_SMALL_REPS; ++rep_) if (PH_MASK & 64) {
            const int ldu = is_lru ? LRU_IN : MLA_INP, moff = is_lru ? 1536 : 672;
            const float qs = 0.125f * 1.4426950408889634f;
            for (int un = bx; un < 512; un += G) { const int qb = un & 63, hh = (un >> 6) & 3, b = un >> 8;
                const size_t base = (size_t)((l * 2 + b) * 4 + hh);
                attn_unit<64, false>(lds, UB + moff + hh * 64, ldu, b * SEQ + qb * 256, mem_q_norm + l * 64, mem_k_norm + l * 64, positions, MEMK + base * 256 * 64, MEMVT + base * 64 * 256, MEML, MIX + 768 + hh * 64, DM, qs); }
        }
        GRID_BAR(); if (PROBE_SYNC2) GRID_BAR();
        {
            pg8::Gemm g{MIX, WOUT + (size_t)l * DM * DM, DM, DM, MTOK, DM, DM}; pg8::StaticOrder S; S.init(g.M, g.N, G, bx);
            pg8::EpiRes E{xout, xout, XB, SSQ + (size_t)(3 * l + 2) * MTOK * 16, 1.0f}; if ((PH_MASK & 2) && (GM_MASK & 128)) pg8::gemm_phase(lds, g, S, E);
        }
        GRID_BAR(); if (PROBE_SYNC2) GRID_BAR();
        {
            pg8::Gemm g{XB, WGU2, DM, DM, MTOK, NGU, DM}; pg8::StaticOrder S; S.init(g.M, g.N, G, bx);
            pg8::EpiSwiglu E{HB, SSQ + (size_t)(3 * l + 2) * MTOK * 16}; for (int rep_ = 0; rep_ < PROBE_GU_REPS; ++rep_) if ((PH_MASK & 2) && (GM_MASK & 256)) pg8::gemm_phase(lds, g, S, E);
        }
        GRID_BAR(); if (PROBE_SYNC2) GRID_BAR();
        {
            pg8::Gemm g{HB, WD2, FF, FF, MTOK, DM, FF}; pg8::StaticOrder S; S.init(g.M, g.N, G, bx);
            pg8::EpiRes E{xout, xout, l == 3 ? (bf16*)nullptr : XB, SSQ + (size_t)(3 * l + 3) * MTOK * 16, 0.5f}; if ((PH_MASK & 2) && (GM_MASK & 512)) pg8::gemm_phase(lds, g, S, E);
        }
        if (l < 3) { GRID_BAR(); if (PROBE_SYNC2) GRID_BAR(); }
    }
}

extern "C" void kernel_launch(void* const* d_in, const int* in_sizes, int n_in, void* d_out, int out_size, void* d_ws, size_t ws_size, hipStream_t stream) {
    static int grid = 0;
    if (grid == 0) {
        if (n_in != 28 || ws_size < WS_END) { fprintf(stderr, "kernel_launch: unexpected n_in %d / ws_size %zu (need %zu)\n", n_in, ws_size, (size_t)WS_END); grid = -1; return; }
        int dev = 0, cus = 0, per_cu = 0;
        hipGetDevice(&dev); hipDeviceGetAttribute(&cus, hipDeviceAttributeMultiprocessorCount, dev);
        if (hipFuncSetAttribute((const void*)mega_fwd, hipFuncAttributeMaxDynamicSharedMemorySize, LDS_BYTES) != hipSuccess) { fprintf(stderr, "kernel_launch: hipFuncSetAttribute failed\n"); }
        if (hipOccupancyMaxActiveBlocksPerMultiprocessor(&per_cu, (const void*)mega_fwd, NTHR, LDS_BYTES) != hipSuccess || per_cu < 1) { fprintf(stderr, "kernel_launch: occupancy query gave %d\n", per_cu); per_cu = 1; }
        (void)hipGetLastError();
        grid = cus * per_cu;
    }
    if (grid < 0) return;
    if (hipMemsetAsync((char*)d_ws + OFF_BAR, 0, 16384, stream) != hipSuccess) { fprintf(stderr, "kernel_launch: memset of barrier words failed\n"); return; }
    Params p{};
    for (int i = 0; i < 28; ++i) p.in[i] = d_in[i];
    p.out = (float*)d_out; p.ws = (unsigned char*)d_ws;
    void* args[] = {&p};
    hipError_t e = hipLaunchCooperativeKernel((const void*)mega_fwd, dim3(grid), dim3(NTHR), args, LDS_BYTES, stream);
    if (e != hipSuccess) fprintf(stderr, "cooperative launch failed: %s (grid %d)\n", hipGetErrorString(e), grid);
}
```
